# Optimizing an MI355X kernel written in HIP

```python
import math
import jax, jax.numpy as jnp
from jax import lax
import numpy as np

D_MODEL = 1024
BATCH = 16
SEQ = 2048
DEPTH = 1

CHUNK = 64
N_META = 16
ATTN_HEADS = 8
ATTN_HEAD_DIM = 64
ATTN_WIDTH = ATTN_HEADS * ATTN_HEAD_DIM
Q_BLOCK = 128
SSM_WIDTH = 512
SSM_GROUP = 16
SSM_GROUPS = SSM_WIDTH // SSM_GROUP
SSM_STATE = 64
D_FF = 2816
CONV_WIDTH = 3
RMS_EPS = 1e-6
SPLITS = (ATTN_WIDTH, 2 * ATTN_WIDTH, 3 * ATTN_WIDTH, 3 * ATTN_WIDTH + ATTN_HEADS,
          3 * ATTN_WIDTH + ATTN_HEADS + SSM_WIDTH)
IN_WIDTH = 3 * ATTN_WIDTH + ATTN_HEADS + SSM_WIDTH + 2 * D_MODEL

kernel_name = "hybrid_fox_s5_convffn_meta"


def _rmsnorm(x, g):
    xf = x.astype(jnp.float32)
    y = xf * lax.rsqrt(jnp.mean(xf * xf, axis=-1, keepdims=True) + RMS_EPS)
    return (y * g.astype(jnp.float32)).astype(x.dtype)


def _forgetting_attention(q, k, v, f_logit, b_forget):
    bsz, seq_len, _ = q.shape
    h, dh = ATTN_HEADS, ATTN_HEAD_DIM
    log_f = jax.nn.log_sigmoid(f_logit.astype(jnp.float32) + b_forget.astype(jnp.float32))
    cum_f = jnp.cumsum(log_f, axis=1)
    lp = -(-seq_len // Q_BLOCK) * Q_BLOCK
    pad = lp - seq_len
    q = jnp.pad(q.reshape(bsz, seq_len, h, dh), ((0, 0), (0, pad), (0, 0), (0, 0)))
    k = jnp.pad(k.reshape(bsz, seq_len, h, dh), ((0, 0), (0, pad), (0, 0), (0, 0)))
    v = jnp.pad(v.reshape(bsz, seq_len, h, dh), ((0, 0), (0, pad), (0, 0), (0, 0)))
    cum_f = jnp.pad(cum_f, ((0, 0), (0, pad), (0, 0)))
    nb = lp // Q_BLOCK
    q_blocks = jnp.moveaxis(q.reshape(bsz, nb, Q_BLOCK, h, dh), 1, 0)
    fq_blocks = jnp.moveaxis(cum_f.reshape(bsz, nb, Q_BLOCK, h), 1, 0)
    q_pos = jnp.arange(lp, dtype=jnp.int32).reshape(nb, Q_BLOCK)
    k_pos = jnp.arange(lp, dtype=jnp.int32)
    fk = jnp.transpose(cum_f, (0, 2, 1))[:, :, None, :]
    scale = 1.0 / math.sqrt(dh)

    def block(args):
        qb, fqb, qp = args
        s = jnp.einsum('bqhd,bkhd->bhqk', qb, k, preferred_element_type=jnp.float32) * scale
        s = s + jnp.transpose(fqb, (0, 2, 1))[..., None] - fk
        mask = k_pos[None, :] <= qp[:, None]
        s = jnp.where(mask[None, None], s, -1e30)
        p = jax.nn.softmax(s, axis=-1)
        return jnp.einsum('bhqk,bkhd->bqhd', p.astype(v.dtype), v)

    out = lax.map(block, (q_blocks, fq_blocks, q_pos))
    out = jnp.moveaxis(out, 0, 1).reshape(bsz, lp, ATTN_WIDTH)
    return out[:, :seq_len]


def _s5(u, lam_re, lam_im, b_re, b_im, c_re, c_im, d_skip, log_dt):
    bsz, seq_len, _ = u.shape
    f32 = jnp.float32
    uf = u.astype(f32)
    ug = uf.reshape(bsz, seq_len, SSM_GROUPS, SSM_GROUP)
    lam = lax.complex(lam_re.astype(f32), lam_im.astype(f32))
    dt = jnp.exp(log_dt.astype(f32))[:, None]
    lam_bar = jnp.exp(lam * dt)
    bmat = lax.complex(b_re.astype(f32), b_im.astype(f32))
    cmat = lax.complex(c_re.astype(f32), c_im.astype(f32))
    b_bar = ((lam_bar - 1.0) / lam)[..., None] * bmat
    bu = jnp.einsum('gpc,blgc->lbgp', b_bar, ug.astype(jnp.complex64))
    a = jnp.broadcast_to(lam_bar, (seq_len, 1, SSM_GROUPS, SSM_STATE))

    def combine(e1, e2):
        a1, b1 = e1
        a2, b2 = e2
        return a1 * a2, a2 * b1 + b2

    _, states = lax.associative_scan(combine, (a, bu), axis=0)
    y = jnp.einsum('gcp,lbgp->blgc', cmat, states).real
    return y.reshape(bsz, seq_len, SSM_WIDTH) + d_skip.astype(f32) * uf


def _mixer(xn, w_in, b_forget, w_attn_out, lam_re, lam_im, b_re, b_im, c_re, c_im,
           d_skip, log_dt, w_glu, w_o):
    proj = xn @ w_in
    q, k, v, f_logit, u, gates = jnp.split(proj, SPLITS, axis=-1)
    y_a = _forgetting_attention(q, k, v, f_logit, b_forget) @ w_attn_out
    z = jax.nn.gelu(_s5(u, lam_re, lam_im, b_re, b_im, c_re, c_im, d_skip, log_dt)).astype(xn.dtype)
    zg = z @ w_glu
    y_s = zg[..., :D_MODEL] * jax.nn.sigmoid(zg[..., D_MODEL:])
    g = jax.nn.sigmoid(gates.astype(jnp.float32))
    merged = g[..., :D_MODEL] * y_a.astype(jnp.float32) + g[..., D_MODEL:] * y_s.astype(jnp.float32)
    return merged.astype(xn.dtype) @ w_o


def _conv_ffn(xn, w_up, conv_w, conv_b, w_down):
    seq_len = xn.shape[1]
    hid = xn @ w_up
    hp = jnp.pad(hid, ((0, 0), (CONV_WIDTH - 1, 0), (0, 0)))
    conv = conv_b + sum(hp[:, j:j + seq_len] * conv_w[j] for j in range(CONV_WIDTH))
    val, gate = jnp.split(conv, 2, axis=-1)
    return (jax.nn.silu(gate) * val) @ w_down


def setup_inputs(seed: int = 0) -> dict:
    key = jax.random.key(seed)
    ks = jax.random.split(key, 24)
    f32 = jnp.float32
    n = lambda k, shape, s: jax.random.normal(k, shape, f32) * s
    L = DEPTH
    log_dt = jax.random.uniform(ks[13], (L, SSM_GROUPS), f32, math.log(1e-3), math.log(1e-1))
    lam_im = jnp.broadcast_to(math.pi * jnp.arange(SSM_STATE, dtype=f32), (L, SSM_GROUPS, SSM_STATE))
    return {
        "x": jax.random.normal(ks[0], (BATCH, SEQ, D_MODEL), f32),
        "meta_tokens": n(ks[1], (N_META, D_MODEL), 1.0),
        "norm_mix_g": 1.0 + n(ks[2], (L, D_MODEL), 0.02),
        "w_in": n(ks[3], (L, D_MODEL, IN_WIDTH), D_MODEL ** -0.5),
        "b_forget": 2.0 + n(ks[4], (L, ATTN_HEADS), 0.5),
        "w_attn_out": n(ks[5], (L, ATTN_WIDTH, D_MODEL), ATTN_WIDTH ** -0.5),
        "ssm_lambda_re": -0.5 + n(ks[6], (L, SSM_GROUPS, SSM_STATE), 0.01),
        "ssm_lambda_im": lam_im + n(ks[7], (L, SSM_GROUPS, SSM_STATE), 0.01),
        "ssm_b_re": n(ks[8], (L, SSM_GROUPS, SSM_STATE, SSM_GROUP), (2 * SSM_GROUP) ** -0.5),
        "ssm_b_im": n(ks[9], (L, SSM_GROUPS, SSM_STATE, SSM_GROUP), (2 * SSM_GROUP) ** -0.5),
        "ssm_c_re": n(ks[10], (L, SSM_GROUPS, SSM_GROUP, SSM_STATE), SSM_STATE ** -0.5),
        "ssm_c_im": n(ks[11], (L, SSM_GROUPS, SSM_GROUP, SSM_STATE), SSM_STATE ** -0.5),
        "ssm_d": n(ks[12], (L, SSM_WIDTH), 1.0),
        "ssm_log_dt": log_dt,
        "w_glu": n(ks[14], (L, SSM_WIDTH, 2 * D_MODEL), SSM_WIDTH ** -0.5),
        "w_o": n(ks[15], (L, D_MODEL, D_MODEL), D_MODEL ** -0.5),
        "norm_ffn_g": 1.0 + n(ks[16], (L, D_MODEL), 0.02),
        "w_ffn_up": n(ks[17], (L, D_MODEL, 2 * D_FF), D_MODEL ** -0.5),
        "ffn_conv_w": n(ks[18], (L, CONV_WIDTH, 2 * D_FF), CONV_WIDTH ** -0.5),
        "ffn_conv_b": n(ks[19], (L, 2 * D_FF), 0.01),
        "w_ffn_down": n(ks[20], (L, D_FF, D_MODEL), D_FF ** -0.5),
        "norm_final_g": 1.0 + n(ks[21], (D_MODEL,), 0.02),
    }


def reference(x, meta_tokens, norm_mix_g, w_in, b_forget, w_attn_out, ssm_lambda_re,
              ssm_lambda_im, ssm_b_re, ssm_b_im, ssm_c_re, ssm_c_im, ssm_d, ssm_log_dt,
              w_glu, w_o, norm_ffn_g, w_ffn_up, ffn_conv_w, ffn_conv_b, w_ffn_down,
              norm_final_g):
    bsz = x.shape[0]
    meta = jnp.broadcast_to(meta_tokens.astype(x.dtype)[None], (bsz, N_META, x.shape[-1]))
    h = jnp.concatenate([meta, x], axis=1)
    for layer in range(DEPTH):
        xn = _rmsnorm(h, norm_mix_g[layer])
        h = h + _mixer(xn, w_in[layer], b_forget[layer], w_attn_out[layer],
                       ssm_lambda_re[layer], ssm_lambda_im[layer], ssm_b_re[layer],
                       ssm_b_im[layer], ssm_c_re[layer], ssm_c_im[layer], ssm_d[layer],
                       ssm_log_dt[layer], w_glu[layer], w_o[layer])
        xn = _rmsnorm(h, norm_ffn_g[layer])
        h = h + _conv_ffn(xn, w_ffn_up[layer], ffn_conv_w[layer], ffn_conv_b[layer],
                          w_ffn_down[layer])
    h = _rmsnorm(h, norm_final_g)
    return h[:, N_META:]
```

```cpp
#include <hip/hip_runtime.h>
#include <hip/hip_cooperative_groups.h>
#include <cstdio>
#include <cstdint>
namespace cg = cooperative_groups;

#ifndef MK_PER_PHASE
#define MK_PER_PHASE 0
#endif

constexpr int NB = 16, SEQ = 2048, NMETA = 16, DM = 1024, MROWS = NB * SEQ;
constexpr int NH = 8, DH = 64, AW = 512, SW = 512, NG = 32, NP = 64, FF = 2816, FF2 = 5632, INW = 4104;
constexpr int LTOT = SEQ + NMETA;
constexpr float RMS_EPS = 1e-6f;
constexpr float LOG2E = 1.4426950408889634f;
constexpr int NPHASE = 9;
namespace pg8 {
#define PG8_LAS __attribute__((address_space(3)))
typedef unsigned short bf16_t;
typedef short bf16x8 __attribute__((ext_vector_type(8)));
typedef float f32x4 __attribute__((ext_vector_type(4)));
typedef unsigned u32x4 __attribute__((ext_vector_type(4)));
constexpr int BM = 256, BK = 64, HALF = 128, HTB = HALF * BK * 2  , STAGE_BYTES = 8 * HTB, NXCD = 8, WGM = 8;

__host__ __device__ __forceinline__ int lds_byte(int r, int c) { const int st = (r >> 4) * 2 + (c >> 5), rr = r & 15, cc = c & 31, ob = rr * 64 + cc * 2; return st * 1024 + (ob ^ (((ob >> 9) & 1) << 5)); }
__host__ __device__ __forceinline__ void stage_rc(int b, int& R, int& C) { const int st = b / 1024, sb = b % 1024, swz = sb ^ (((sb >> 9) & 1) << 5); R = (st >> 1) * 16 + swz / 64; C = (st & 1) * 32 + (swz % 64) / 2; }
__host__ __device__ __forceinline__ int perm32(int rho) { const int n = rho >> 4, i = rho & 15; return 8 * (i >> 2) + 4 * n + (i & 3); }

struct Unit { int pm, pn; };
struct Gemm { const bf16_t* A; const bf16_t* Bt; int M, N, K; };

struct StaticOrder {
    int nM, nN, nwg, G, c;
    __host__ __device__ void init(int M, int N, int G_, int c_) { nM = M / BM; nN = N / BM; nwg = nM * nN; G = G_; c = c_; }
    __host__ __device__ bool next(int i, Unit& u) const {
        const long L = (long)i * G + c; if (L >= nwg) return false;
        int wgid = (int)L; { const int q = nwg / NXCD, r = nwg % NXCD, xcd = wgid % NXCD, off = wgid / NXCD; wgid = (xcd < r ? xcd * (q + 1) : r * (q + 1) + (xcd - r) * q) + off; }
        const int nig = WGM * nN, gid = wgid / nig, fm = gid * WGM, gsz = (nM - fm) < WGM ? (nM - fm) : WGM;
        u.pm = fm + ((wgid % nig) % gsz); u.pn = (wgid % nig) / gsz; return true;
    }
    __device__ __forceinline__ void a_ready(const Unit&) const {}
    __device__ __forceinline__ void done(const Unit&) const {}
};

__device__ __forceinline__ unsigned cvt_pk_bf16(float lo, float hi) { unsigned r; asm volatile("v_cvt_pk_bf16_f32 %0, %1, %2" : "=v"(r) : "v"(lo), "v"(hi)); return r; }
typedef float f32x2 __attribute__((ext_vector_type(2)));
typedef unsigned u32x4e __attribute__((ext_vector_type(4)));
typedef unsigned u32x2e __attribute__((ext_vector_type(2)));
__device__ __forceinline__ float fsig(float x) { return __builtin_amdgcn_rcpf(1.0f + __builtin_amdgcn_exp2f(-1.4426950408889634f * x)); }
__device__ __forceinline__ float bf_lo(unsigned w) { return __uint_as_float(w << 16); }
__device__ __forceinline__ float bf_hi(unsigned w) { return __uint_as_float(w & 0xffff0000u); }

struct EpiProj {
    static constexpr bool PERM = true, AFTER_DRAIN = false;
    bf16_t* QKVU; bf16_t* GATE;
    __device__ __forceinline__ void operator()(const f32x4 (&acc)[2][2][4][2], const Unit& u, int wr, int wc, int fr, int fq) const {
        const int row0 = u.pm * BM + wr * 64 + fr;
        const bool isg = u.pn >= 8;
        bf16_t* base; int ldc, colt;
        if (!isg) { base = QKVU + (size_t)(u.pn >> 1) * ((size_t)32768 * 512); ldc = 512; colt = (u.pn & 1) * 256; }
        else { base = GATE; ldc = 2048; colt = (u.pn - 8) * 256; }
        const int col0 = colt + wc * 32 + 8 * fq;
#pragma unroll
        for (int ai = 0; ai < 2; ++ai)
#pragma unroll
            for (int m = 0; m < 4; ++m) { bf16_t* rowp = base + (size_t)(row0 + ai * HALF + m * 16) * ldc + col0;
#pragma unroll
                for (int bj = 0; bj < 2; ++bj) { f32x4 v0 = acc[ai][bj][m][0], v1 = acc[ai][bj][m][1];
                    if (isg) { v0 = (f32x4){fsig(v0[0]), fsig(v0[1]), fsig(v0[2]), fsig(v0[3])}; v1 = (f32x4){fsig(v1[0]), fsig(v1[1]), fsig(v1[2]), fsig(v1[3])}; }
                    u32x4e w; w.x = cvt_pk_bf16(v0[0], v0[1]); w.y = cvt_pk_bf16(v0[2], v0[3]); w.z = cvt_pk_bf16(v1[0], v1[1]); w.w = cvt_pk_bf16(v1[2], v1[3]);
                    *(u32x4e*)(rowp + bj * HALF) = w; } }
    }
};

struct EpiYa {
    static constexpr bool PERM = true, AFTER_DRAIN = false;
    const bf16_t* GATE; float* PART;
    __device__ __forceinline__ void operator()(const f32x4 (&acc)[2][2][4][2], const Unit& u, int wr, int wc, int fr, int fq) const {
        const int row0 = u.pm * BM + wr * 64 + fr, col0 = u.pn * BM + wc * 32 + 8 * fq;
#pragma unroll
        for (int ai = 0; ai < 2; ++ai)
#pragma unroll
            for (int m = 0; m < 4; ++m) { const size_t row = (size_t)(row0 + ai * HALF + m * 16);
#pragma unroll
                for (int bj = 0; bj < 2; ++bj) { const int col = col0 + bj * HALF;
                    const u32x4e g = *(const u32x4e*)(GATE + row * 2048 + col);
                    f32x4 v0 = acc[ai][bj][m][0], v1 = acc[ai][bj][m][1];
                    v0 = v0 * (f32x4){bf_lo(g.x), bf_hi(g.x), bf_lo(g.y), bf_hi(g.y)}; v1 = v1 * (f32x4){bf_lo(g.z), bf_hi(g.z), bf_lo(g.w), bf_hi(g.w)};
                    float* p = PART + row * 1024 + col; *(f32x4*)p = v0; *(f32x4*)(p + 4) = v1; } }
    }
};

struct EpiGlu {
    static constexpr bool PERM = true, AFTER_DRAIN = false;
    const bf16_t* GATE; const float* PART; bf16_t* MERGED;
    __device__ __forceinline__ void operator()(const f32x4 (&acc)[2][2][4][2], const Unit& u, int wr, int wc, int fr, int fq) const {
        const int row0 = u.pm * BM + wr * 64 + fr, col = u.pn * HALF + wc * 32 + 8 * fq;
#pragma unroll
        for (int ai = 0; ai < 2; ++ai)
#pragma unroll
            for (int m = 0; m < 4; ++m) { const size_t row = (size_t)(row0 + ai * HALF + m * 16);
                const u32x4e g = *(const u32x4e*)(GATE + row * 2048 + 1024 + col);
                const float* p = PART + row * 1024 + col; const f32x4 p0 = *(const f32x4*)p, p1 = *(const f32x4*)(p + 4);
                const f32x4 a0 = acc[ai][0][m][0], a1 = acc[ai][0][m][1], b0 = acc[ai][1][m][0], b1 = acc[ai][1][m][1];
                f32x4 y0 = (f32x4){a0[0] * fsig(b0[0]), a0[1] * fsig(b0[1]), a0[2] * fsig(b0[2]), a0[3] * fsig(b0[3])};
                f32x4 y1 = (f32x4){a1[0] * fsig(b1[0]), a1[1] * fsig(b1[1]), a1[2] * fsig(b1[2]), a1[3] * fsig(b1[3])};
                y0 = p0 + y0 * (f32x4){bf_lo(g.x), bf_hi(g.x), bf_lo(g.y), bf_hi(g.y)}; y1 = p1 + y1 * (f32x4){bf_lo(g.z), bf_hi(g.z), bf_lo(g.w), bf_hi(g.w)};
                u32x4e w; w.x = cvt_pk_bf16(y0[0], y0[1]); w.y = cvt_pk_bf16(y0[2], y0[3]); w.z = cvt_pk_bf16(y1[0], y1[1]); w.w = cvt_pk_bf16(y1[2], y1[3]);
                *(u32x4e*)(MERGED + row * 1024 + col) = w; }
    }
};

template <bool WITH_BF> struct EpiRes {
    static constexpr bool PERM = true, AFTER_DRAIN = false;
    const float* base; float* out; bf16_t* OB; float* rowss;
    __device__ __forceinline__ void operator()(const f32x4 (&acc)[2][2][4][2], const Unit& u, int wr, int wc, int fr, int fq) const {
        const int row0 = u.pm * BM + wr * 64 + fr, col0 = u.pn * BM + wc * 32 + 8 * fq;
#pragma unroll
        for (int ai = 0; ai < 2; ++ai)
#pragma unroll
            for (int m = 0; m < 4; ++m) { const size_t row = (size_t)(row0 + ai * HALF + m * 16); float ss = 0.f;
#pragma unroll
                for (int bj = 0; bj < 2; ++bj) { const size_t off = row * 1024 + col0 + bj * HALF;
                    const f32x4 r0 = *(const f32x4*)(base + off), r1 = *(const f32x4*)(base + off + 4);
                    const f32x4 v0 = acc[ai][bj][m][0] + r0, v1 = acc[ai][bj][m][1] + r1;
                    *(f32x4*)(out + off) = v0; *(f32x4*)(out + off + 4) = v1;
                    ss += (v0[0] * v0[0] + v0[1] * v0[1]) + (v0[2] * v0[2] + v0[3] * v0[3]) + (v1[0] * v1[0] + v1[1] * v1[1]) + (v1[2] * v1[2] + v1[3] * v1[3]);
                    if (WITH_BF) { u32x4e w; w.x = cvt_pk_bf16(v0[0], v0[1]); w.y = cvt_pk_bf16(v0[2], v0[3]); w.z = cvt_pk_bf16(v1[0], v1[1]); w.w = cvt_pk_bf16(v1[2], v1[3]);
                        *(u32x4e*)(OB + off) = w; } }
                ss += __shfl_xor(ss, 16); ss += __shfl_xor(ss, 32);
                if (fq == 0) atomicAdd(rowss + row, ss); }
    }
};

struct EpiUp {
    static constexpr bool PERM = true, AFTER_DRAIN = false;
    const float* rowss; const float* CP; bf16_t* ACT; float* EDGE;
    __device__ __forceinline__ void operator()(const f32x4 (&acc)[2][2][4][2], const Unit& u, int wr, int wc, int fr, int fq) const {
        const int lane = fq * 16 + fr;
        const int ch0 = u.pn * HALF + wc * 32 + 8 * fq;
        const int idx1 = ((lane & ~15) | ((fr - 1) & 15)) << 2, idx2 = ((lane & ~15) | ((fr - 2) & 15)) << 2;
        const bool s15 = fr == 15, s14 = fr >= 14;
        const bool edge = fr < 2 || fr >= 14; const int slot = fr < 2 ? fr : fr - 12;
        const unsigned cpo = (unsigned)ch0 * 32u;
#pragma unroll
        for (int ai = 0; ai < 2; ++ai) {
            const int rowb = u.pm * BM + ai * HALF + wr * 64;
            const unsigned rso = (unsigned)(rowb + fr) * 4u;
            float rs[4];
#pragma unroll
            for (int m = 0; m < 4; ++m) rs[m] = rsqrtf(*(const float*)((const char*)rowss + rso + m * 64) * (1.0f / 1024.0f) + 1e-6f);
            const unsigned ebo = ((unsigned)(rowb >> 6) * 2816u + (unsigned)ch0) * 32u + (unsigned)slot * 4u;
            const unsigned aco = ((unsigned)(rowb + fr) * 2816u + (unsigned)ch0) * 2u;
#pragma unroll
            for (int n = 0; n < 2; ++n) {
                float ov[4][4];
#pragma unroll
                for (int e = 0; e < 4; ++e) {
                    const f32x4 wv = *(const f32x4*)((const char*)CP + cpo + (4 * n + e) * 32), wg = *(const f32x4*)((const char*)CP + cpo + (4 * n + e) * 32 + 16);
                    float hv[4], hg[4];
#pragma unroll
                    for (int m = 0; m < 4; ++m) { hv[m] = acc[ai][0][m][n][e] * rs[m]; hg[m] = acc[ai][1][m][n][e] * rs[m]; }
                    if (edge) { const float ev = fr < 2 ? hv[0] : hv[3], eg = fr < 2 ? hg[0] : hg[3];
                        *(float*)((char*)EDGE + ebo + (4 * n + e) * 32) = ev; *(float*)((char*)EDGE + ebo + (4 * n + e) * 32 + 16) = eg; }
#pragma unroll
                    for (int m = 0; m < 4; ++m) {
                        const float pv = m > 0 ? hv[m - 1] : 0.f, pg = m > 0 ? hg[m - 1] : 0.f;
                        const float v1 = __int_as_float(__builtin_amdgcn_ds_bpermute(idx1, __float_as_int(s15 ? pv : hv[m])));
                        const float v2 = __int_as_float(__builtin_amdgcn_ds_bpermute(idx2, __float_as_int(s14 ? pv : hv[m])));
                        const float g1 = __int_as_float(__builtin_amdgcn_ds_bpermute(idx1, __float_as_int(s15 ? pg : hg[m])));
                        const float g2 = __int_as_float(__builtin_amdgcn_ds_bpermute(idx2, __float_as_int(s14 ? pg : hg[m])));
                        const float o1 = wv[3] + wv[0] * v2 + wv[1] * v1 + wv[2] * hv[m];
                        const float og = wg[3] + wg[0] * g2 + wg[1] * g1 + wg[2] * hg[m];
                        ov[m][e] = og * fsig(og) * o1;
                    }
                }
#pragma unroll
                for (int m = 0; m < 4; ++m) { u32x2e w; w.x = cvt_pk_bf16(ov[m][0], ov[m][1]); w.y = cvt_pk_bf16(ov[m][2], ov[m][3]);
                    *(u32x2e*)((char*)ACT + aco + (unsigned)(m * 16 * 2816 * 2) + n * 8) = w; }
                asm volatile("" ::: "memory");
            }
        }
    }
};

struct PairOrder {
    int G, c, per;
    __device__ bool next(int i, Unit& u) const { const int su = (i / per) * G + c; if (su >= 256) return false; u.pm = su >> 1; u.pn = (su & 1) * per + (i % per); return true; }
    __device__ __forceinline__ void a_ready(const Unit&) const {}
    __device__ __forceinline__ void done(const Unit&) const {}
};

template <class Epi, class Sched, bool ALIGN_EPI = false, bool SP2 = false>
__device__ __forceinline__ void gemm_phase(PG8_LAS unsigned char* lds, const Gemm g, const Sched& S, const Epi& E) {
    const int tid = threadIdx.x, wid = __builtin_amdgcn_readfirstlane(tid >> 6), lane = tid & 63, wr = wid >> 2, wc = wid & 3, fr = lane & 15, fq = lane >> 4;
    const int K = g.K, nt = K / BK;
    unsigned voffA[2], voffB[2];
#pragma unroll
    for (int i = 0; i < 2; ++i) { int R, C; stage_rc(tid * 16 + i * 8192, R, C); const int Rb = Epi::PERM ? ((R & ~31) + perm32(R & 31)) : R;
        voffA[i] = (unsigned)(R * K + C) * 2u; voffB[i] = (unsigned)(Rb * K + C) * 2u; }
    const size_t kstep = (size_t)(BK * 2);
    const size_t hstep = (size_t)HALF * K * 2;
    const size_t tstep = 2 * hstep;
    const unsigned ldsw = (unsigned)wid * 1024u;
    const int aoff = lds_byte(wr * 64 + fr, fq * 8), boff = lds_byte(wc * 32 + fr, fq * 8);
#define PG8_SA(b, h) (((b) * 2 + (h)) * HTB)
#define PG8_SB(b, h) ((4 + (b) * 2 + (h)) * HTB)
#define PG8_STAGE(bufoff, gbase, voff) do { _Pragma("unroll") for (int _i = 0; _i < 2; ++_i) \
        __builtin_amdgcn_global_load_lds((const unsigned*)((const char*)(gbase) + (voff)[_i]), (PG8_LAS unsigned*)(lds + (bufoff) + ldsw + _i * 8192), 16, 0, 0); } while (0)
#define PG8_LDA(dst, b, h) do { _Pragma("unroll") for (int m = 0; m < 4; ++m) _Pragma("unroll") for (int k = 0; k < 2; ++k) dst[m][k] = *(const PG8_LAS bf16x8*)(lds + PG8_SA(b, h) + aoff + m * 2048 + k * 1024); } while (0)
#define PG8_LDB(dst, b, h) do { _Pragma("unroll") for (int n = 0; n < 2; ++n) _Pragma("unroll") for (int k = 0; k < 2; ++k) dst[n][k] = *(const PG8_LAS bf16x8*)(lds + PG8_SB(b, h) + boff + n * 2048 + k * 1024); } while (0)
#define PG8_MMA(ai, bj, At, Bt) do { __builtin_amdgcn_s_setprio(1); _Pragma("unroll") for (int m = 0; m < 4; ++m) _Pragma("unroll") for (int n = 0; n < 2; ++n) _Pragma("unroll") for (int k = 0; k < 2; ++k) \
        acc[ai][bj][m][n] = __builtin_amdgcn_mfma_f32_16x16x32_bf16(Bt[n][k], At[m][k], acc[ai][bj][m][n], 0, 0, 0); __builtin_amdgcn_s_setprio(0); } while (0)
#define PG8_WAIT_V(n) asm volatile("s_waitcnt vmcnt(" #n ")" ::: "memory")
#define PG8_WAIT_L(n) asm volatile("s_waitcnt lgkmcnt(" #n ")" ::: "memory")
#define PG8_BAR __builtin_amdgcn_s_barrier()
#define PG8_SCHED __builtin_amdgcn_sched_barrier(0)
    Unit cur, nxt; int ui = 0;
    if (!S.next(0, cur)) return;
    f32x4 acc[2][2][4][2];
#pragma unroll
    for (int a = 0; a < 2; ++a)
#pragma unroll
        for (int b = 0; b < 2; ++b)
#pragma unroll
            for (int m = 0; m < 4; ++m)
#pragma unroll
                for (int n = 0; n < 2; ++n) acc[a][b][m][n] = (f32x4){0.f, 0.f, 0.f, 0.f};
    bf16x8 At[4][2], B0[2][2], B1[2][2];
    const char* cA = (const char*)g.A + (size_t)cur.pm * tstep; const char* cB = (const char*)g.Bt + (size_t)cur.pn * tstep;
    S.a_ready(cur);
    if constexpr (SP2) {
        PG8_STAGE(PG8_SB(0, 0), cB, voffB); PG8_STAGE(PG8_SB(0, 1), cB + hstep, voffB); PG8_STAGE(PG8_SA(0, 0), cA, voffA); PG8_STAGE(PG8_SA(0, 1), cA + hstep, voffA);
        if (wr == 1) PG8_BAR;
        PG8_WAIT_V(2); PG8_BAR;
        PG8_STAGE(PG8_SB(1, 0), cB + kstep, voffB); PG8_STAGE(PG8_SA(1, 0), cA + kstep, voffA); PG8_STAGE(PG8_SB(1, 1), cB + hstep + kstep, voffB);
        PG8_WAIT_V(6); PG8_BAR;
    } else {
        PG8_STAGE(PG8_SB(0, 0), cB, voffB); PG8_STAGE(PG8_SA(0, 0), cA, voffA); PG8_STAGE(PG8_SB(0, 1), cB + hstep, voffB); PG8_STAGE(PG8_SA(0, 1), cA + hstep, voffA);
        if (wr == 1) PG8_BAR;
        PG8_WAIT_V(4); PG8_BAR;
        PG8_STAGE(PG8_SB(1, 0), cB + kstep, voffB); PG8_STAGE(PG8_SA(1, 0), cA + kstep, voffA); PG8_STAGE(PG8_SB(1, 1), cB + hstep + kstep, voffB);
        PG8_WAIT_V(6); PG8_BAR;
    }
    for (;;) {
        const bool has_next = S.next(ui + 1, nxt);
        const char* nA = has_next ? (const char*)g.A + (size_t)nxt.pm * tstep : cA; const char* nB = has_next ? (const char*)g.Bt + (size_t)nxt.pn * tstep : cB;
        for (int t = 0; t < nt; t += 2) {
            const bool last = (t == nt - 2);
            const char* a1 = cA + (size_t)(t + 1) * kstep;
            const char* a2 = last ? nA : cA + (size_t)(t + 2) * kstep; const char* b2 = last ? nB : cB + (size_t)(t + 2) * kstep;
            const char* a3 = a2 + kstep; const char* b3 = b2 + kstep;
            if (last && has_next) S.a_ready(nxt);
            if constexpr (SP2) {
            PG8_LDB(B0, 0, 0); PG8_LDB(B1, 0, 1); PG8_SCHED; PG8_LDA(At, 0, 0); PG8_STAGE(PG8_SA(1, 1), a1 + hstep, voffA);
            PG8_WAIT_V(8); PG8_WAIT_L(0); PG8_BAR; PG8_MMA(0, 0, At, B0); PG8_MMA(0, 1, At, B1); PG8_BAR; PG8_SCHED;
            PG8_LDA(At, 0, 1); PG8_STAGE(PG8_SB(0, 0), b2, voffB); PG8_STAGE(PG8_SB(0, 1), b2 + hstep, voffB); PG8_STAGE(PG8_SA(0, 0), a2, voffA);
            PG8_WAIT_V(8); PG8_WAIT_L(0); PG8_BAR; PG8_MMA(1, 0, At, B0); PG8_MMA(1, 1, At, B1); PG8_BAR; PG8_SCHED;
            PG8_LDB(B0, 1, 0); PG8_LDB(B1, 1, 1); PG8_SCHED; PG8_LDA(At, 1, 0); PG8_STAGE(PG8_SA(0, 1), a2 + hstep, voffA);
            PG8_WAIT_V(8); PG8_WAIT_L(0); PG8_BAR; PG8_MMA(0, 0, At, B0); PG8_MMA(0, 1, At, B1); PG8_BAR; PG8_SCHED;
            PG8_LDA(At, 1, 1); PG8_STAGE(PG8_SB(1, 0), b3, voffB); PG8_STAGE(PG8_SB(1, 1), b3 + hstep, voffB); PG8_STAGE(PG8_SA(1, 0), a3, voffA);
            PG8_WAIT_V(8); PG8_WAIT_L(0); PG8_BAR; PG8_MMA(1, 0, At, B0); PG8_MMA(1, 1, At, B1); PG8_BAR; PG8_SCHED;
            } else {
            PG8_LDB(B0, 0, 0); PG8_SCHED; PG8_LDA(At, 0, 0); PG8_STAGE(PG8_SA(1, 1), a1 + hstep, voffA);
            PG8_WAIT_L(8); PG8_BAR; PG8_WAIT_L(0); PG8_MMA(0, 0, At, B0); PG8_BAR; PG8_SCHED;
            PG8_LDB(B1, 0, 1); PG8_STAGE(PG8_SB(0, 0), b2, voffB);
            PG8_BAR; PG8_WAIT_L(0); PG8_MMA(0, 1, At, B1); PG8_BAR;
            PG8_LDA(At, 0, 1); PG8_STAGE(PG8_SA(0, 0), a2, voffA);
            PG8_BAR; PG8_WAIT_L(0); PG8_MMA(1, 0, At, B0); PG8_BAR; PG8_SCHED;
            PG8_STAGE(PG8_SB(0, 1), b2 + hstep, voffB);
            PG8_WAIT_V(6); PG8_BAR; PG8_MMA(1, 1, At, B1); PG8_BAR;
            PG8_LDB(B0, 1, 0); PG8_SCHED; PG8_LDA(At, 1, 0); PG8_STAGE(PG8_SA(0, 1), a2 + hstep, voffA);
            PG8_WAIT_L(8); PG8_BAR; PG8_WAIT_L(0); PG8_MMA(0, 0, At, B0); PG8_BAR; PG8_SCHED;
            PG8_LDB(B1, 1, 1); PG8_STAGE(PG8_SB(1, 0), b3, voffB);
            PG8_BAR; PG8_WAIT_L(0); PG8_MMA(0, 1, At, B1); PG8_BAR;
            PG8_LDA(At, 1, 1); PG8_STAGE(PG8_SA(1, 0), a3, voffA);
            PG8_BAR; PG8_WAIT_L(0); PG8_MMA(1, 0, At, B0); PG8_BAR; PG8_SCHED;
            PG8_STAGE(PG8_SB(1, 1), b3 + hstep, voffB);
            PG8_WAIT_V(6); PG8_BAR; PG8_MMA(1, 1, At, B1); PG8_BAR;
            }
        }
        if constexpr (ALIGN_EPI) { if (wr == 0) PG8_BAR; }
        if constexpr (!Epi::AFTER_DRAIN) { E(acc, cur, wr, wc, fr, fq); S.done(cur); }
        if (!has_next) break;
#pragma unroll
        for (int a = 0; a < 2; ++a)
#pragma unroll
            for (int b = 0; b < 2; ++b)
#pragma unroll
                for (int m = 0; m < 4; ++m)
#pragma unroll
                    for (int n = 0; n < 2; ++n) acc[a][b][m][n] = (f32x4){0.f, 0.f, 0.f, 0.f};
        cur = nxt; cA = nA; cB = nB; ++ui;
        if constexpr (ALIGN_EPI) { if (wr == 1) PG8_BAR; }
    }
    PG8_WAIT_V(0);
    if constexpr (!ALIGN_EPI) { if (wr == 0) PG8_BAR; }
    PG8_BAR;
    if constexpr (Epi::AFTER_DRAIN) { E.fused(acc, cur, wr, wc, fr, fq, lds, wid, lane); S.done(cur); }
#undef PG8_SA
#undef PG8_SB
#undef PG8_STAGE
#undef PG8_LDA
#undef PG8_LDB
#undef PG8_MMA
#undef PG8_WAIT_V
#undef PG8_WAIT_L
#undef PG8_BAR
#undef PG8_SCHED
}
}

#define LAS __attribute__((address_space(3)))
typedef unsigned short bf16;
typedef short bf16x8 __attribute__((ext_vector_type(8)));
typedef float f32x4 __attribute__((ext_vector_type(4)));
typedef float f32x16 __attribute__((ext_vector_type(16)));
typedef unsigned v4u __attribute__((ext_vector_type(4)));
typedef unsigned v2u __attribute__((ext_vector_type(2)));
typedef float f32x2v __attribute__((ext_vector_type(2)));
typedef __bf16 bf16x2n __attribute__((ext_vector_type(2)));
#define LDS_WAIT() asm volatile("s_waitcnt lgkmcnt(0)" ::: "memory")
__device__ __forceinline__ unsigned pk2(float lo, float hi) { f32x2v v = {lo, hi}; return __builtin_bit_cast(unsigned, __builtin_convertvector(v, bf16x2n)); }
__device__ __forceinline__ float bf2f(bf16 h) { return __uint_as_float((unsigned)h << 16); }
__device__ __forceinline__ float blo(unsigned w) { return __uint_as_float(w << 16); }
__device__ __forceinline__ float bhi(unsigned w) { return __uint_as_float(w & 0xffff0000u); }
__device__ __forceinline__ float fsigm(float x) { return __builtin_amdgcn_rcpf(1.0f + __builtin_amdgcn_exp2f(-LOG2E * x)); }
__device__ __forceinline__ float wave_sum(float v) {
#pragma unroll
    for (int o = 1; o < 64; o <<= 1) v += __shfl_xor(v, o);
    return v;
}

constexpr size_t MiB = 1u << 20;
constexpr size_t WS_ROWSS1 = 0, WS_ROWSS2 = 128 * 1024;
constexpr size_t WS_LOGFM = 256 * 1024;
constexpr size_t WS_XNM = 1 * MiB;
constexpr size_t WS_QKVUM = WS_XNM + 64 * 1024;
constexpr size_t WS_GATEM = WS_QKVUM + 64 * 1024;
constexpr size_t WS_AA = WS_GATEM + 64 * 1024, WS_ZA = WS_AA + 16 * 1024;
constexpr size_t WS_MA = WS_ZA + 16 * 1024, WS_HA = WS_MA + 32 * 1024;
constexpr size_t WS_EDGEM = WS_HA + 32 * 1024;
constexpr size_t WS_CP = WS_EDGEM + 64 * 1024;
constexpr size_t WS_LOGF = 2 * MiB;
constexpr size_t WS_CUMF = 3 * MiB;
constexpr size_t WS_WIN = 6 * MiB, WS_WA = 14 * MiB, WS_WG = 15 * MiB, WS_WO = 17 * MiB, WS_WUP = 19 * MiB, WS_WDN = 30 * MiB;
constexpr size_t WS_RA = 36 * MiB;
constexpr size_t WS_RB = 100 * MiB;
constexpr size_t WS_QKVU = 164 * MiB;
constexpr size_t WS_GATE = 292 * MiB;
constexpr size_t WS_ACT = 164 * MiB;
constexpr size_t WS_EDGE = 420 * MiB;
constexpr size_t WS_END = 464 * MiB;
constexpr int LDS_BYTES = 135168;

struct Args { const float* in[22]; float* out; unsigned char* ws; int ph_lo, ph_hi; };

struct Frame {
    LAS unsigned char* lds; unsigned char* ws; const float* const* in; float* out;
    int tid, lane, wave, vcu, G;
};

__device__ __forceinline__ void tr_item(const float* W, int K, int Nsrc, bf16* WT, int src_col0, int dst_row0, int k0, const float* gk, LAS float* scr, int lane) {
#pragma unroll 8
    for (int i = 0; i < 32; ++i) { const int kk = 2 * i + (lane >> 5); float v = W[(size_t)(k0 + kk) * Nsrc + src_col0 + (lane & 31)]; if (gk) v *= gk[k0 + kk]; scr[kk * 33 + (lane & 31)] = v; }
    LDS_WAIT(); asm volatile("" ::: "memory");
    const int c = lane & 7;
#pragma unroll
    for (int j = 0; j < 4; ++j) { const int n = (lane >> 3) + 8 * j; const LAS float* s = scr + (8 * c) * 33 + n;
        v4u o; o.x = pk2(s[0 * 33], s[1 * 33]); o.y = pk2(s[2 * 33], s[3 * 33]); o.z = pk2(s[4 * 33], s[5 * 33]); o.w = pk2(s[6 * 33], s[7 * 33]);
        *(v4u*)(WT + (size_t)(dst_row0 + n) * K + k0 + 8 * c) = o; }
    LDS_WAIT(); asm volatile("" ::: "memory");
}
__device__ __forceinline__ float log_sigmoid(float x) { return x >= 0.f ? -log1pf(expf(-x)) : x - log1pf(expf(x)); }

__device__ __forceinline__ void norm_row(const float* xrow, const f32x4 (&gv)[4], bf16* orow, const LAS float* wf, const float* bfg, float* lf, int lane) {
    const f32x4* xr = (const f32x4*)xrow + lane;
    f32x4 v[4]; float s = 0.f;
#pragma unroll
    for (int j = 0; j < 4; ++j) { v[j] = xr[64 * j]; s += (v[j].x * v[j].x + v[j].y * v[j].y) + (v[j].z * v[j].z + v[j].w * v[j].w); }
    const float rstd = rsqrtf(wave_sum(s) * (1.f / DM) + RMS_EPS);
    float fa[8];
#pragma unroll
    for (int q = 0; q < 8; ++q) fa[q] = 0.f;
    unsigned long long* o8 = (unsigned long long*)orow + lane;
#pragma unroll
    for (int j = 0; j < 4; ++j) { v[j] = v[j] * rstd * gv[j];
        o8[64 * j] = (unsigned long long)pk2(v[j].x, v[j].y) | ((unsigned long long)pk2(v[j].z, v[j].w) << 32);
#pragma unroll
        for (int e = 0; e < 4; ++e) { const LAS f32x4* wp = (const LAS f32x4*)(wf + (size_t)(256 * j + 4 * lane + e) * 8); const f32x4 w0 = wp[0], w1 = wp[1]; const float xv = v[j][e];
            fa[0] += xv * w0.x; fa[1] += xv * w0.y; fa[2] += xv * w0.z; fa[3] += xv * w0.w; fa[4] += xv * w1.x; fa[5] += xv * w1.y; fa[6] += xv * w1.z; fa[7] += xv * w1.w; } }
    float mine = 0.f;
#pragma unroll
    for (int q = 0; q < 8; ++q) { const float t = wave_sum(fa[q]); if (lane == q) mine = t; }
    if (lane < 8) lf[lane] = log_sigmoid(mine + bfg[lane]);
}

__device__ __forceinline__ void p0_prologue(Frame& F) {
    const int gw = F.vcu * 8 + F.wave, NGW = F.G * 8, lane = F.lane;
    const float* const* in = F.in;
    { float* z = (float*)(F.ws + WS_ROWSS1); for (int i = blockIdx.x * 512 + F.tid; i < 2 * 32768; i += F.G * 512) z[i] = 0.f; }
    { float* cp = (float*)(F.ws + WS_CP); for (int i = blockIdx.x * 512 + F.tid; i < FF * 8; i += F.G * 512) { const int c = i >> 3, k = i & 7, cc = c + (k >= 4 ? FF : 0), kk = k & 3; cp[i] = kk < 3 ? in[18][kk * FF2 + cc] : in[19][cc]; } }
    LAS float* wf = (LAS float*)(F.lds);
    for (int i = F.tid; i < 1024 * 8; i += 512) wf[i] = in[3][(size_t)(i >> 3) * INW + 1536 + (i & 7)];
    __syncthreads();
    LAS float* scr = (LAS float*)(F.lds + 32768 + F.wave * 9216);
    constexpr int I_IN = 16 * 128, I_A = 8 * 32, I_G = 8 * 64, I_O = 16 * 32, I_UP = 16 * 176, I_DN = 44 * 32;
    constexpr int NITEMS = I_IN + I_A + I_G + I_O + I_UP + I_DN;
    for (int it = gw; it < NITEMS; it += NGW) {
        int r = it;
        if (r < I_IN) { const int kb = r / 128, db = r % 128; tr_item(in[3], 1024, INW, (bf16*)(F.ws + WS_WIN), db < 48 ? 32 * db : 1544 + 32 * (db - 48), 32 * db, 64 * kb, nullptr, scr, lane); continue; } r -= I_IN;
        if (r < I_A) { const int kb = r / 32, db = r % 32; tr_item(in[5], 512, 1024, (bf16*)(F.ws + WS_WA), 32 * db, 32 * db, 64 * kb, nullptr, scr, lane); continue; } r -= I_A;
        if (r < I_G) { const int kb = r / 64, db = r % 64, pn = db >> 3, wi = db & 7; tr_item(in[14], 512, 2048, (bf16*)(F.ws + WS_WG), wi < 4 ? 128 * pn + 32 * wi : 1024 + 128 * pn + 32 * (wi - 4), 32 * db, 64 * kb, nullptr, scr, lane); continue; } r -= I_G;
        if (r < I_O) { const int kb = r / 32, db = r % 32; tr_item(in[15], 1024, 1024, (bf16*)(F.ws + WS_WO), 32 * db, 32 * db, 64 * kb, nullptr, scr, lane); continue; } r -= I_O;
        if (r < I_UP) { const int kb = r / 176, db = r % 176, pn = db >> 3, wi = db & 7; tr_item(in[17], 1024, FF2, (bf16*)(F.ws + WS_WUP), wi < 4 ? 128 * pn + 32 * wi : FF + 128 * pn + 32 * (wi - 4), 32 * db, 64 * kb, in[16], scr, lane); continue; } r -= I_UP;
        { const int kb = r / 32, db = r % 32; tr_item(in[20], FF, 1024, (bf16*)(F.ws + WS_WDN), 32 * db, 32 * db, 64 * kb, nullptr, scr, lane); }
    }
    f32x4 gv[4];
#pragma unroll
    for (int j = 0; j < 4; ++j) gv[j] = ((const f32x4*)in[2])[lane + 64 * j];
    bf16* XN = (bf16*)(F.ws + WS_RA); float* LOGF = (float*)(F.ws + WS_LOGF);
    for (int m = gw; m < MROWS + NMETA; m += NGW) {
        if (m < MROWS) norm_row(in[0] + (size_t)m * DM, gv, XN + (size_t)m * DM, wf, in[4], LOGF + (size_t)m * 8, lane);
        else { const int r = m - MROWS; norm_row(in[1] + (size_t)r * DM, gv, (bf16*)(F.ws + WS_XNM) + (size_t)r * DM, wf, in[4], (float*)(F.ws + WS_LOGFM) + r * 8, lane); }
    }
}

__device__ __forceinline__ f32x4 skinny_tile(const bf16* A, const bf16* Bt, int K, int ct, int lane) {
    const bf16* ap = A + (size_t)(lane & 15) * K + 8 * (lane >> 4);
    const bf16* bp = Bt + (size_t)(16 * ct + (lane & 15)) * K + 8 * (lane >> 4);
    f32x4 acc = {0.f, 0.f, 0.f, 0.f};
    for (int s = 0; s < K / 32; s += 8) {
        bf16x8 a[8], b[8];
#pragma unroll
        for (int q = 0; q < 8; ++q) { a[q] = *(const bf16x8*)(ap + 32 * (s + q)); b[q] = *(const bf16x8*)(bp + 32 * (s + q)); }
#pragma unroll
        for (int q = 0; q < 8; ++q) acc = __builtin_amdgcn_mfma_f32_16x16x32_bf16(a[q], b[q], acc, 0, 0, 0);
    }
    return acc;
}

__device__ __forceinline__ void p1_extras(Frame& F) {
    const int gw = F.vcu * 8 + F.wave, NGW = F.G * 8, lane = F.lane;
    for (int ct = gw; ct < 256; ct += NGW) {
        const f32x4 acc = skinny_tile((const bf16*)(F.ws + WS_XNM), (const bf16*)(F.ws + WS_WIN), 1024, ct, lane);
        const int col = 16 * ct + (lane & 15), fq = lane >> 4;
#pragma unroll
        for (int i = 0; i < 4; ++i) { const int r = 4 * fq + i;
            if (col < 2048) ((bf16*)(F.ws + WS_QKVUM))[(size_t)(col >> 9) * (16 * 512) + r * 512 + (col & 511)] = (bf16)(pk2(acc[i], 0.f) & 0xffffu);
            else ((bf16*)(F.ws + WS_GATEM))[r * 2048 + (col - 2048)] = (bf16)(pk2(fsigm(acc[i]), 0.f) & 0xffffu); }
    }
    const float* LOGF = (const float*)(F.ws + WS_LOGF); const float* LOGFM = (const float*)(F.ws + WS_LOGFM); float* CUMF = (float*)(F.ws + WS_CUMF);
    for (int sq = gw; sq < NB * NH; sq += NGW) { const int b = sq >> 3, h = sq & 7; float carry = 0.f;
        for (int p0 = 0; p0 < LTOT; p0 += 64) { const int p = p0 + lane;
            float v = 0.f; if (p < LTOT) v = p < NMETA ? LOGFM[p * 8 + h] : LOGF[(size_t)(b * SEQ + p - NMETA) * 8 + h];
#pragma unroll
            for (int o = 1; o < 64; o <<= 1) { const float t = __shfl_up(v, o); if (lane >= o) v += t; }
            v += carry; if (p < LTOT) CUMF[(size_t)sq * LTOT + p] = v; carry = __shfl(v, 63); } }
}

struct S5Regs { float l0r, l0i, l1r, l1i; bf16x8 Bf[4]; bf16x8 Cm[4]; float dsk; };
__device__ __forceinline__ void cw_sincos(float x, float& s, float& c) { s = sinf(x); c = cosf(x); }
__device__ __forceinline__ void s5_setup(const float* const* in, int g, int lane, S5Regs& R) {
    const int j = lane & 31, kq5 = lane >> 5;
    const float dt = expf(in[13][g]);
#pragma unroll
    for (int wh = 0; wh < 2; ++wh) { const int p = j + 32 * wh;
        const float lr = in[6][g * 64 + p], li = in[7][g * 64 + p];
        const float a = lr * dt, b = li * dt, ea = expf(a); float sb, cb; cw_sincos(b, sb, cb);
        const float lbr = ea * cb, lbi = ea * sb;
        const float sh = sinf(0.5f * b), nre = expm1f(a) * cb - 2.f * sh * sh, nim = ea * sb;
        const float den = 1.0f / (lr * lr + li * li), cre = (nre * lr + nim * li) * den, cim = (nim * lr - nre * li) * den;
        const f32x4* br = (const f32x4*)(in[8] + ((size_t)(g * 64 + p) * 16 + 8 * kq5)); const f32x4* bi = (const f32x4*)(in[9] + ((size_t)(g * 64 + p) * 16 + 8 * kq5));
        const f32x4 r0 = br[0], r1 = br[1], i0 = bi[0], i1 = bi[1];
        v4u re, im;
        re.x = pk2(cre * r0.x - cim * i0.x, cre * r0.y - cim * i0.y); re.y = pk2(cre * r0.z - cim * i0.z, cre * r0.w - cim * i0.w);
        re.z = pk2(cre * r1.x - cim * i1.x, cre * r1.y - cim * i1.y); re.w = pk2(cre * r1.z - cim * i1.z, cre * r1.w - cim * i1.w);
        im.x = pk2(cre * i0.x + cim * r0.x, cre * i0.y + cim * r0.y); im.y = pk2(cre * i0.z + cim * r0.z, cre * i0.w + cim * r0.w);
        im.z = pk2(cre * i1.x + cim * r1.x, cre * i1.y + cim * r1.y); im.w = pk2(cre * i1.z + cim * r1.z, cre * i1.w + cim * r1.w);
        R.Bf[2 * wh] = __builtin_bit_cast(bf16x8, re); R.Bf[2 * wh + 1] = __builtin_bit_cast(bf16x8, im);
        if (wh == 0) { R.l0r = lbr; R.l0i = lbi; } else { R.l1r = lbr; R.l1i = lbi; } }
    const int c = lane & 15, kq = lane >> 4;
    const float* cr = in[10] + (size_t)(g * 16 + c) * 64; const float* ci = in[11] + (size_t)(g * 16 + c) * 64;
#pragma unroll
    for (int s = 0; s < 4; ++s) { const int ja = 8 * s + 2 * kq, jb = ja + 1; v4u w;
        w.x = pk2(cr[ja], -ci[ja]); w.y = pk2(cr[ja + 32], -ci[ja + 32]); w.z = pk2(cr[jb], -ci[jb]); w.w = pk2(cr[jb + 32], -ci[jb + 32]);
        R.Cm[s] = __builtin_bit_cast(bf16x8, w); }
    R.dsk = in[12][g * 16 + c];
}
constexpr int S5_XP = 136;
template <bool FULL, class ZST>
__device__ __forceinline__ void s5_chunk(const S5Regs& R, const bf16* up, float (&x)[4], LAS bf16* X, LAS bf16* Ut, int lane, const ZST& zst) {
    const bf16x8 a = *(const bf16x8*)up;
    f32x16 bu[4];
    const f32x16 zero = {0.f, 0.f, 0.f, 0.f, 0.f, 0.f, 0.f, 0.f, 0.f, 0.f, 0.f, 0.f, 0.f, 0.f, 0.f, 0.f};
#pragma unroll
    for (int q = 0; q < 4; ++q) bu[q] = __builtin_amdgcn_mfma_f32_32x32x16_bf16(a, R.Bf[q], zero, 0, 0, 0);
    const int j = lane & 31, hi = lane >> 5;
    if (FULL) { const int i = lane & 31, th = (i >> 2) & 1, r = (i & 3) + 4 * (i >> 3); *(LAS bf16x8*)(Ut + (16 * th + r) * 16 + 8 * hi) = a; }
#pragma unroll
    for (int r = 0; r < 16; ++r) {
        const float n0r = fmaf(R.l0r, x[0], fmaf(-R.l0i, x[1], bu[0][r])), n0i = fmaf(R.l0r, x[1], fmaf(R.l0i, x[0], bu[1][r]));
        const float n1r = fmaf(R.l1r, x[2], fmaf(-R.l1i, x[3], bu[2][r])), n1i = fmaf(R.l1r, x[3], fmaf(R.l1i, x[2], bu[3][r]));
        x[0] = n0r; x[1] = n0i; x[2] = n1r; x[3] = n1i;
        if (FULL) { v2u w; w.x = pk2(n0r, n0i); w.y = pk2(n1r, n1i); *(LAS v2u*)(X + (16 * hi + r) * S5_XP + 4 * j) = w; }
    }
    if (FULL) {
        LDS_WAIT(); asm volatile("" ::: "memory");
        const int c = lane & 15, fq = lane >> 4;
#pragma unroll
        for (int th = 0; th < 2; ++th) { f32x4 acc = {0.f, 0.f, 0.f, 0.f};
#pragma unroll
            for (int s = 0; s < 4; ++s) { const bf16x8 xa = *(const LAS bf16x8*)(X + (16 * th + c) * S5_XP + 32 * s + 8 * fq); acc = __builtin_amdgcn_mfma_f32_16x16x32_bf16(xa, R.Cm[s], acc, 0, 0, 0); }
#pragma unroll
            for (int i = 0; i < 4; ++i) { const int r = 4 * fq + i; const float y = acc[i] + R.dsk * bf2f(Ut[(16 * th + r) * 16 + c]);
                const float uu = 0.7978845608028654f * (y + 0.044715f * y * y * y); zst(th, r, c, y * fsigm(2.f * uu)); } }
        LDS_WAIT(); asm volatile("" ::: "memory");
    }
}
struct ZNone { __device__ __forceinline__ void operator()(int, int, int, float) const {} };
struct ZMain { bf16* z0; bf16* z1; __device__ __forceinline__ void operator()(int th, int r, int c, float v) const { (th ? z1 : z0)[(size_t)r * 512 + c] = (bf16)(pk2(v, 0.f) & 0xffffu); } };
struct ZMeta { bf16* za; __device__ __forceinline__ void operator()(int th, int r, int c, float v) const { if (th == 0 && r >= 14) za[(r - 14) * 512 + c] = (bf16)(pk2(v, 0.f) & 0xffffu); } };

__device__ __forceinline__ void s5_unit(Frame& F, int g, int bp) {
    const int lane = F.lane, w = F.wave;
    LAS bf16* X = (LAS bf16*)(F.lds + w * 10240); LAS bf16* Ut = (LAS bf16*)(F.lds + w * 10240 + 8704);
    LAS float* Ex = (LAS float*)(F.lds + 81920);
    S5Regs R; s5_setup(F.in, g, lane, R);
    const bf16* U = (const bf16*)(F.ws + WS_QKVU) + (size_t)3 * MROWS * 512; const bf16* UM = (const bf16*)(F.ws + WS_QKVUM) + 3 * 16 * 512;
    bf16* Z = (bf16*)(F.ws + WS_RB + 32 * MiB);
    const int i = lane & 31, kq5 = lane >> 5, th = (i >> 2) & 1, r = (i & 3) + 4 * (i >> 3);
    const bf16* upm = UM + r * 512 + 16 * g + 8 * kq5;
    const int t0 = 256 * w;
    const bf16* up0 = U + ((size_t)((2 * bp + th) * SEQ + t0 + r)) * 512 + 16 * g + 8 * kq5;
    float x[4] = {0.f, 0.f, 0.f, 0.f}; float xm[4] = {0.f, 0.f, 0.f, 0.f};
    if (w == 0) { s5_chunk<false>(R, upm, x, X, Ut, lane, ZNone{}); xm[0] = x[0]; xm[1] = x[1]; xm[2] = x[2]; xm[3] = x[3]; }
    for (int c = 0; c < 16; ++c) s5_chunk<false>(R, up0 + (size_t)c * 16 * 512, x, X, Ut, lane, ZNone{});
    *(LAS f32x4*)(Ex + (w * 64 + lane) * 4) = (f32x4){x[0], x[1], x[2], x[3]};
    __syncthreads();
    float p0r = R.l0r, p0i = R.l0i, p1r = R.l1r, p1i = R.l1i;
#pragma unroll
    for (int q = 0; q < 8; ++q) { const float a = p0r * p0r - p0i * p0i, b = 2.f * p0r * p0i, c2 = p1r * p1r - p1i * p1i, d = 2.f * p1r * p1i; p0r = a; p0i = b; p1r = c2; p1i = d; }
    if (w == 0) { x[0] = xm[0]; x[1] = xm[1]; x[2] = xm[2]; x[3] = xm[3]; }
    else { f32x4 e = *(const LAS f32x4*)(Ex + lane * 4);
        for (int v = 1; v < w; ++v) { const f32x4 ev = *(const LAS f32x4*)(Ex + (v * 64 + lane) * 4);
            const float a = ev[0] + p0r * e[0] - p0i * e[1], b = ev[1] + p0r * e[1] + p0i * e[0], c2 = ev[2] + p1r * e[2] - p1i * e[3], d = ev[3] + p1r * e[3] + p1i * e[2]; e = (f32x4){a, b, c2, d}; }
        x[0] = e[0]; x[1] = e[1]; x[2] = e[2]; x[3] = e[3]; }
    for (int c = 0; c < 16; ++c) { const int t = t0 + 16 * c;
        ZMain zs{Z + ((size_t)((2 * bp) * SEQ + t)) * 512 + 16 * g, Z + ((size_t)((2 * bp + 1) * SEQ + t)) * 512 + 16 * g};
        s5_chunk<true>(R, up0 + (size_t)c * 16 * 512, x, X, Ut, lane, zs); }
    __syncthreads();
}

__device__ __forceinline__ void meta_chain(Frame& F) {
    const int tid = F.tid, lane = F.lane, w = F.wave;
    const float* const* in = F.in;
    bf16* aA = (bf16*)(F.ws + WS_AA); bf16* zA = (bf16*)(F.ws + WS_ZA); bf16* mA = (bf16*)(F.ws + WS_MA); bf16* hA = (bf16*)(F.ws + WS_HA);
    const bf16* QM = (const bf16*)(F.ws + WS_QKVUM); const bf16* KM = QM + 16 * 512; const bf16* VM = KM + 16 * 512; const bf16* UM = VM + 16 * 512;
    const bf16* GM = (const bf16*)(F.ws + WS_GATEM); const float* LOGFM = (const float*)(F.ws + WS_LOGFM);
    LAS float* MRG = (LAS float*)(F.lds + 90112);
    LAS float* PM = (LAS float*)(F.lds + 98304);
    LAS float* RED = (LAS float*)(F.lds + 99328);
    for (int i = tid; i < (16 * 512 * 2 + 16 * 1024 * 2) / 2; i += 512) ((unsigned*)aA)[i] = 0u;
    __syncthreads();
    { LAS bf16* X = (LAS bf16*)(F.lds + w * 10240); LAS bf16* Ut = (LAS bf16*)(F.lds + w * 10240 + 8704);
      const int i = lane & 31, kq5 = lane >> 5, r = (i & 3) + 4 * (i >> 3);
      for (int g = w; g < NG; g += 8) { S5Regs R; s5_setup(in, g, lane, R); float x[4] = {0.f, 0.f, 0.f, 0.f};
          s5_chunk<true>(R, UM + r * 512 + 16 * g + 8 * kq5, x, X, Ut, lane, ZMeta{zA + 16 * g}); } }
    if (tid < 256) { const int h = tid >> 5, qi = (tid >> 4) & 1, key = tid & 15, qp = 14 + qi;
        float s = 0.f;
        for (int d = 0; d < 64; ++d) s += bf2f(QM[qp * 512 + 64 * h + d]) * bf2f(KM[key * 512 + 64 * h + d]);
        float fq = 0.f, fk = 0.f;
        for (int p = 0; p < 16; ++p) { const float lf = LOGFM[p * 8 + h]; if (p <= qp) fq += lf; if (p <= key) fk += lf; }
        s = s * 0.125f + fq - fk; if (key > qp) s = -1e30f;
        float mx = s;
#pragma unroll
        for (int o = 1; o < 16; o <<= 1) mx = fmaxf(mx, __shfl_xor(mx, o));
        float p = expf(s - mx), sum = p;
#pragma unroll
        for (int o = 1; o < 16; o <<= 1) sum += __shfl_xor(sum, o);
        PM[(h * 2 + qi) * 16 + key] = p / sum; }
    __syncthreads();
    for (int o = tid; o < 1024; o += 512) { const int qi = o >> 9, col = o & 511, h = col >> 6; float a = 0.f;
        for (int k = 0; k < 16; ++k) a += PM[(h * 2 + qi) * 16 + k] * bf2f(VM[k * 512 + col]);
        aA[qi * 512 + col] = (bf16)(pk2(a, 0.f) & 0xffffu); }
    __syncthreads();
    for (int ct = w; ct < 64; ct += 8) { const f32x4 acc = skinny_tile(aA, (const bf16*)(F.ws + WS_WA), 512, ct, lane);
        if (lane < 16) { const int col = 16 * ct + lane; MRG[col] = acc[0] * bf2f(GM[14 * 2048 + col]); MRG[1024 + col] = acc[1] * bf2f(GM[15 * 2048 + col]); } }
    __syncthreads();
    for (int pi = w; pi < 64; pi += 8) { const int pn = pi >> 3, wi = pi & 7;
        const f32x4 av = skinny_tile(zA, (const bf16*)(F.ws + WS_WG), 512, 16 * pn + wi, lane), ag = skinny_tile(zA, (const bf16*)(F.ws + WS_WG), 512, 16 * pn + 8 + wi, lane);
        if (lane < 16) { const int ch = 128 * pn + 16 * wi + lane;
            const float m0 = MRG[ch] + bf2f(GM[14 * 2048 + 1024 + ch]) * av[0] * fsigm(ag[0]), m1 = MRG[1024 + ch] + bf2f(GM[15 * 2048 + 1024 + ch]) * av[1] * fsigm(ag[1]);
            mA[ch] = (bf16)(pk2(m0, 0.f) & 0xffffu); mA[1024 + ch] = (bf16)(pk2(m1, 0.f) & 0xffffu); } }
    __syncthreads();
    for (int ct = w; ct < 64; ct += 8) { const f32x4 acc = skinny_tile(mA, (const bf16*)(F.ws + WS_WO), 1024, ct, lane);
        if (lane < 16) { const int col = 16 * ct + lane; MRG[col] = in[1][14 * 1024 + col] + acc[0]; MRG[1024 + col] = in[1][15 * 1024 + col] + acc[1]; } }
    __syncthreads();
    { float s0 = 0.f, s1 = 0.f;
      for (int c = tid; c < 1024; c += 512) { const float a = MRG[c], b = MRG[1024 + c]; s0 += a * a; s1 += b * b; hA[c] = (bf16)(pk2(a, 0.f) & 0xffffu); hA[1024 + c] = (bf16)(pk2(b, 0.f) & 0xffffu); }
      s0 = wave_sum(s0); s1 = wave_sum(s1); if (lane == 0) { RED[w] = s0; RED[8 + w] = s1; } }
    __syncthreads();
    if (tid < 2) { float s = 0.f; for (int q = 0; q < 8; ++q) s += RED[tid * 8 + q]; RED[16 + tid] = rsqrtf(s * (1.f / 1024.f) + RMS_EPS); }
    __syncthreads();
    { const float r0 = RED[16], r1 = RED[17]; float* EM = (float*)(F.ws + WS_EDGEM);
      for (int ct = w; ct < 352; ct += 8) { const f32x4 acc = skinny_tile(hA, (const bf16*)(F.ws + WS_WUP), 1024, ct, lane);
          if (lane < 16) { const int pn = ct >> 4, wi = ct & 15; const int hc = wi < 8 ? 128 * pn + 16 * wi + lane : FF + 128 * pn + 16 * (wi - 8) + lane;
              EM[hc] = r0 * acc[0]; EM[FF2 + hc] = r1 * acc[1]; } } }
    __syncthreads();
}

__device__ __forceinline__ int crow(int r, int hi) { return (r & 3) + 8 * (r >> 2) + 4 * hi; }
constexpr int AT_KP = 72, AT_VP = 68, AT_BUF = 64 * AT_KP * 2 + 64 * AT_VP * 2 + 256;
__device__ __forceinline__ void attn_unit(Frame& F, int b, int h, int qb) {
    const int tid = F.tid, lane = F.lane, w = F.wave, q = lane & 31, hi = lane >> 5;
    const bf16* Q = (const bf16*)(F.ws + WS_QKVU); const bf16* K = Q + (size_t)MROWS * 512; const bf16* V = K + (size_t)MROWS * 512;
    const bf16* KM = (const bf16*)(F.ws + WS_QKVUM) + 16 * 512; const bf16* VM = KM + 16 * 512;
    const float* CF = (const float*)(F.ws + WS_CUMF) + (size_t)(b * 8 + h) * LTOT;
    bf16* ATT = (bf16*)(F.ws + WS_RB);
    const int t0w = 256 * qb + 32 * w, pq = NMETA + t0w + q;
    const size_t rowq = (size_t)b * SEQ + t0w + q;
    bf16x8 Qf[4];
#pragma unroll
    for (int s = 0; s < 4; ++s) Qf[s] = *(const bf16x8*)(Q + rowq * 512 + 64 * h + 16 * s + 8 * hi);
    const float Fq = CF[pq] * LOG2E;
    const int ntiles = 4 * qb + 5, jmax = 4 * qb + ((32 * w + 47) >> 6);
    float mrun = -1e30f, lrun = 0.f;
    f32x16 O0, O1;
#pragma unroll
    for (int r = 0; r < 16; ++r) { O0[r] = 0.f; O1[r] = 0.f; }
    const int skey = tid >> 3, sch = tid & 7;
    v4u kreg, vreg; float fkreg = 0.f;
#define AT_LOAD(jt) do { const int p_ = 64 * (jt) + skey; const bf16 *kp_, *vp_; \
        if (p_ < NMETA) { kp_ = KM + p_ * 512; vp_ = VM + p_ * 512; } else { int rr_ = p_ - NMETA; rr_ = rr_ > SEQ - 1 ? SEQ - 1 : rr_; kp_ = K + ((size_t)b * SEQ + rr_) * 512; vp_ = V + ((size_t)b * SEQ + rr_) * 512; } \
        kreg = *(const v4u*)(kp_ + 64 * h + 8 * sch); vreg = *(const v4u*)(vp_ + 64 * h + 8 * sch); \
        if (tid < 64) { int pf_ = 64 * (jt) + tid; pf_ = pf_ > LTOT - 1 ? LTOT - 1 : pf_; fkreg = CF[pf_] * LOG2E; } } while (0)
    AT_LOAD(0);
    for (int jt = 0; jt < ntiles; ++jt) {
        LAS unsigned char* buf = F.lds + (jt & 1) * AT_BUF;
        LAS bf16* Ks = (LAS bf16*)buf; LAS bf16* Vt = (LAS bf16*)(buf + 64 * AT_KP * 2); LAS float* Fk = (LAS float*)(buf + 64 * AT_KP * 2 + 64 * AT_VP * 2);
        *(LAS v4u*)(Ks + skey * AT_KP + 8 * sch) = kreg;
        { const unsigned vv[4] = {vreg.x, vreg.y, vreg.z, vreg.w};
#pragma unroll
          for (int e = 0; e < 4; ++e) { Vt[(8 * sch + 2 * e) * AT_VP + skey] = (bf16)(vv[e] & 0xffffu); Vt[(8 * sch + 2 * e + 1) * AT_VP + skey] = (bf16)(vv[e] >> 16); } }
        if (tid < 64) Fk[tid] = fkreg;
        __syncthreads();
        if (jt + 1 < ntiles) AT_LOAD(jt + 1);
        if (jt <= jmax) {
            f32x16 p0, p1;
#pragma unroll
            for (int r = 0; r < 16; ++r) { p0[r] = 0.f; p1[r] = 0.f; }
#pragma unroll
            for (int s = 0; s < 4; ++s) {
                const bf16x8 k0 = *(const LAS bf16x8*)(Ks + q * AT_KP + 16 * s + 8 * hi), k1 = *(const LAS bf16x8*)(Ks + (32 + q) * AT_KP + 16 * s + 8 * hi);
                p0 = __builtin_amdgcn_mfma_f32_32x32x16_bf16(k0, Qf[s], p0, 0, 0, 0); p1 = __builtin_amdgcn_mfma_f32_32x32x16_bf16(k1, Qf[s], p1, 0, 0, 0); }
            const bool need_mask = (64 * jt + 63) > (NMETA + t0w);
            float mx = -1e30f;
#pragma unroll
            for (int g4 = 0; g4 < 4; ++g4) { const f32x4 f0 = *(const LAS f32x4*)(Fk + 8 * g4 + 4 * hi), f1 = *(const LAS f32x4*)(Fk + 32 + 8 * g4 + 4 * hi);
#pragma unroll
                for (int e = 0; e < 4; ++e) { const int r = 4 * g4 + e;
                    float a = fmaf(p0[r], 0.125f * LOG2E, Fq - f0[e]), c = fmaf(p1[r], 0.125f * LOG2E, Fq - f1[e]);
                    if (need_mask) { const int pk = 64 * jt + 8 * g4 + 4 * hi + e; if (pk > pq) a = -1e30f; if (pk + 32 > pq) c = -1e30f; }
                    p0[r] = a; p1[r] = c; mx = fmaxf(mx, fmaxf(a, c)); } }
            mx = fmaxf(mx, __shfl_xor(mx, 32));
            const float mnew = fmaxf(mrun, mx), alpha = __builtin_amdgcn_exp2f(mrun - mnew); mrun = mnew;
            float ps = 0.f;
#pragma unroll
            for (int r = 0; r < 16; ++r) { p0[r] = __builtin_amdgcn_exp2f(p0[r] - mnew); p1[r] = __builtin_amdgcn_exp2f(p1[r] - mnew); ps += p0[r] + p1[r]; }
            lrun = lrun * alpha + ps;
#pragma unroll
            for (int r = 0; r < 16; ++r) { O0[r] *= alpha; O1[r] *= alpha; }
#pragma unroll
            for (int t = 0; t < 4; ++t) {
                v4u pw;
                if (t < 2) { const int o = 8 * (t & 1); pw.x = pk2(p0[o], p0[o + 1]); pw.y = pk2(p0[o + 2], p0[o + 3]); pw.z = pk2(p0[o + 4], p0[o + 5]); pw.w = pk2(p0[o + 6], p0[o + 7]); }
                else { const int o = 8 * (t & 1); pw.x = pk2(p1[o], p1[o + 1]); pw.y = pk2(p1[o + 2], p1[o + 3]); pw.z = pk2(p1[o + 4], p1[o + 5]); pw.w = pk2(p1[o + 6], p1[o + 7]); }
                const bf16x8 pb = __builtin_bit_cast(bf16x8, pw);
                const int key0 = 32 * (t >> 1) + 16 * (t & 1) + 4 * hi;
                const v2u a0 = *(const LAS v2u*)(Vt + q * AT_VP + key0), a1 = *(const LAS v2u*)(Vt + q * AT_VP + key0 + 8);
                const v2u b0 = *(const LAS v2u*)(Vt + (32 + q) * AT_VP + key0), b1 = *(const LAS v2u*)(Vt + (32 + q) * AT_VP + key0 + 8);
                const v4u va = {a0.x, a0.y, a1.x, a1.y}, vb = {b0.x, b0.y, b1.x, b1.y};
                O0 = __builtin_amdgcn_mfma_f32_32x32x16_bf16(__builtin_bit_cast(bf16x8, va), pb, O0, 0, 0, 0);
                O1 = __builtin_amdgcn_mfma_f32_32x32x16_bf16(__builtin_bit_cast(bf16x8, vb), pb, O1, 0, 0, 0);
            }
        }
    }
#undef AT_LOAD
    const float inv = 1.0f / (lrun + __shfl_xor(lrun, 32));
    bf16* op = ATT + rowq * 512 + 64 * h;
#pragma unroll
    for (int g4 = 0; g4 < 4; ++g4) { v2u w0, w1;
        w0.x = pk2(O0[4 * g4] * inv, O0[4 * g4 + 1] * inv); w0.y = pk2(O0[4 * g4 + 2] * inv, O0[4 * g4 + 3] * inv);
        w1.x = pk2(O1[4 * g4] * inv, O1[4 * g4 + 1] * inv); w1.y = pk2(O1[4 * g4 + 2] * inv, O1[4 * g4 + 3] * inv);
        *(v2u*)(op + 8 * g4 + 4 * hi) = w0; *(v2u*)(op + 32 + 8 * g4 + 4 * hi) = w1; }
    __syncthreads();
}

__device__ __forceinline__ void p6_fixup(Frame& F) {
    const float* EDGE = (const float*)(F.ws + WS_EDGE); const float* EM = (const float*)(F.ws + WS_EDGEM);
    const float* CP = (const float*)(F.ws + WS_CP); bf16* ACT = (bf16*)(F.ws + WS_ACT);
    const int total = 512 * 2 * (FF / 4);
    for (int i = blockIdx.x * 512 + F.tid; i < total; i += F.G * 512) {
        const int c4 = (i % (FF / 4)) * 4, rr = (i / (FF / 4)) & 1, rb = i / (2 * (FF / 4));
        const bool first = (rb & 31) == 0;
        float o[4];
#pragma unroll
        for (int e = 0; e < 4; ++e) { const int c = c4 + e;
            const float* e0 = EDGE + ((size_t)rb * FF + c) * 8; const float* ep = EDGE + ((size_t)(rb - 1) * FF + c) * 8;
            float v2, v1, v0, g2, g1, g0;
            if (rr == 0) { v0 = e0[0]; g0 = e0[4];
                if (first) { v2 = EM[c]; g2 = EM[FF + c]; v1 = EM[FF2 + c]; g1 = EM[FF2 + FF + c]; } else { v2 = ep[2]; g2 = ep[6]; v1 = ep[3]; g1 = ep[7]; } }
            else { v0 = e0[1]; g0 = e0[5]; v1 = e0[0]; g1 = e0[4];
                if (first) { v2 = EM[FF2 + c]; g2 = EM[FF2 + FF + c]; } else { v2 = ep[3]; g2 = ep[7]; } }
            const float* cp = CP + c * 8;
            const float ov = cp[3] + cp[0] * v2 + cp[1] * v1 + cp[2] * v0;
            const float og = cp[7] + cp[4] * g2 + cp[5] * g1 + cp[6] * g0;
            o[e] = og * fsigm(og) * ov; }
        v2u w; w.x = pk2(o[0], o[1]); w.y = pk2(o[2], o[3]);
        *(v2u*)(ACT + (size_t)(64 * rb + rr) * FF + c4) = w;
    }
}

__device__ __forceinline__ void p8_final(Frame& F) {
    const int gw = F.vcu * 8 + F.wave, NGW = F.G * 8, lane = F.lane;
    const float* rowss = (const float*)(F.ws + WS_ROWSS2);
    f32x4 gv[4];
#pragma unroll
    for (int j = 0; j < 4; ++j) gv[j] = ((const f32x4*)F.in[21])[lane + 64 * j];
    for (int m = gw; m < MROWS; m += NGW) { const float rstd = rsqrtf(rowss[m] * (1.f / DM) + RMS_EPS); f32x4* o = (f32x4*)(F.out + (size_t)m * DM) + lane;
#pragma unroll
        for (int j = 0; j < 4; ++j) o[64 * j] = o[64 * j] * rstd * gv[j]; }
}

#ifndef MK_SKIP
#define MK_SKIP 0
#endif
__global__ void __launch_bounds__(512, 2) mk_fwd(Args args) {
    extern __shared__ __attribute__((aligned(16))) unsigned char lds_raw[];
    Frame F;
    F.lds = (LAS unsigned char*)lds_raw; F.ws = args.ws; F.in = args.in; F.out = args.out;
    F.tid = threadIdx.x; F.lane = F.tid & 63; F.wave = __builtin_amdgcn_readfirstlane(F.tid >> 6);
    F.G = gridDim.x; { const int bx = blockIdx.x; F.vcu = (F.G % 8 == 0) ? (bx % 8) * (F.G / 8) + bx / 8 : bx; }
    const int lo = args.ph_lo, hi = args.ph_hi;
#define IN(k) (lo <= (k) && (k) < hi)
#define SEAM(k) do { if (IN(k) && IN((k) + 1)) cg::this_grid().sync(); } while (0)
    unsigned char* ws = args.ws;
    bf16* QKVU = (bf16*)(ws + WS_QKVU); bf16* GATE = (bf16*)(ws + WS_GATE);

#if !((MK_SKIP >> 0) & 1)
    if (IN(0)) { p0_prologue(F); __syncthreads(); }
#endif
    SEAM(0);

#if !((MK_SKIP >> 1) & 1)
    if (IN(1)) {
        p1_extras(F);
        pg8::Gemm g{(const bf16*)(ws + WS_RA), (const bf16*)(ws + WS_WIN), MROWS, 4096, 1024}; pg8::StaticOrder S; S.init(MROWS, 4096, F.G, (int)blockIdx.x);
        pg8::EpiProj E{QKVU, GATE};
        pg8::gemm_phase<pg8::EpiProj, pg8::StaticOrder, true, true>(F.lds, g, S, E);
    }
#endif
    SEAM(1);

#if !((MK_SKIP >> 2) & 1)
    if (IN(2)) {
        for (int u = F.vcu; u < 256; u += F.G) s5_unit(F, u & 31, u >> 5);
        if (blockIdx.x == 0) meta_chain(F);
        for (int pu = F.vcu; pu < 512; pu += F.G) { const int bh = pu >> 2, qp = pu & 3; attn_unit(F, bh >> 3, bh & 7, 7 - qp); attn_unit(F, bh >> 3, bh & 7, qp); }
    }
#endif
    SEAM(2);

#if !((MK_SKIP >> 3) & 1)
    if (IN(3)) {
        { pg8::Gemm g{(const bf16*)(ws + WS_RB), (const bf16*)(ws + WS_WA), MROWS, 1024, 512}; pg8::PairOrder S{F.G, F.vcu, 2};
          pg8::EpiYa E{GATE, F.out};
          pg8::gemm_phase<pg8::EpiYa, pg8::PairOrder, true, true>(F.lds, g, S, E); }
        { pg8::Gemm g{(const bf16*)(ws + WS_RB + 32 * MiB), (const bf16*)(ws + WS_WG), MROWS, 2048, 512}; pg8::PairOrder S{F.G, F.vcu, 4};
          pg8::EpiGlu E{GATE, F.out, (bf16*)(ws + WS_RA)};
          pg8::gemm_phase<pg8::EpiGlu, pg8::PairOrder, true, true>(F.lds, g, S, E); }
    }
#endif
    SEAM(3);

#if !((MK_SKIP >> 4) & 1)
    if (IN(4)) {
        pg8::Gemm g{(const bf16*)(ws + WS_RA), (const bf16*)(ws + WS_WO), MROWS, 1024, 1024}; pg8::StaticOrder S; S.init(MROWS, 1024, F.G, (int)blockIdx.x);
        pg8::EpiRes<true> E{F.in[0], F.out, (bf16*)(ws + WS_RB), (float*)(ws + WS_ROWSS1)};
        pg8::gemm_phase<pg8::EpiRes<true>, pg8::StaticOrder, true, true>(F.lds, g, S, E);
    }
#endif
    SEAM(4);

#if !((MK_SKIP >> 5) & 1)
    if (IN(5)) {
        pg8::Gemm g{(const bf16*)(ws + WS_RB), (const bf16*)(ws + WS_WUP), MROWS, FF2, 1024}; pg8::StaticOrder S; S.init(MROWS, FF2, F.G, (int)blockIdx.x);
        pg8::EpiUp E{(const float*)(ws + WS_ROWSS1), (const float*)(ws + WS_CP), (bf16*)(ws + WS_ACT), (float*)(ws + WS_EDGE)};
        pg8::gemm_phase<pg8::EpiUp, pg8::StaticOrder, true, true>(F.lds, g, S, E);
    }
#endif
    SEAM(5);

#if !((MK_SKIP >> 6) & 1)
    if (IN(6)) { p6_fixup(F); }
#endif
    SEAM(6);

#if !((MK_SKIP >> 7) & 1)
    if (IN(7)) {
        pg8::Gemm g{(const bf16*)(ws + WS_ACT), (const bf16*)(ws + WS_WDN), MROWS, 1024, FF}; pg8::StaticOrder S; S.init(MROWS, 1024, F.G, (int)blockIdx.x);
        pg8::EpiRes<false> E{F.out, F.out, nullptr, (float*)(ws + WS_ROWSS2)};
        pg8::gemm_phase<pg8::EpiRes<false>, pg8::StaticOrder, true, true>(F.lds, g, S, E);
    }
#endif
    SEAM(7);

#if !((MK_SKIP >> 8) & 1)
    if (IN(8)) { p8_final(F); }
#endif
#undef IN
#undef SEAM
}

extern "C" void kernel_launch(void* const* d_in, const int* in_sizes, int n_in, void* d_out, int out_size, void* d_ws, size_t ws_size, hipStream_t stream) {
    static int grid = 0;
    if (grid == 0) {
        if (n_in != 22 || in_sizes[0] != MROWS * DM || out_size != MROWS * DM || ws_size < WS_END) { fprintf(stderr, "kernel_launch: unexpected shapes / workspace (n_in %d, ws %zu)\n", n_in, ws_size); grid = -1; return; }
        int dev = 0, cus = 0, per_cu = 0;
        if (hipGetDevice(&dev) != hipSuccess || hipDeviceGetAttribute(&cus, hipDeviceAttributeMultiprocessorCount, dev) != hipSuccess) { grid = -1; return; }
        if (hipFuncSetAttribute((const void*)mk_fwd, hipFuncAttributeMaxDynamicSharedMemorySize, LDS_BYTES) != hipSuccess) { fprintf(stderr, "kernel_launch: hipFuncSetAttribute failed\n"); grid = -1; return; }
        if (hipOccupancyMaxActiveBlocksPerMultiprocessor(&per_cu, (const void*)mk_fwd, 512, LDS_BYTES) != hipSuccess || per_cu < 1) { fprintf(stderr, "kernel_launch: occupancy query failed (%d)\n", per_cu); (void)hipGetLastError(); per_cu = 1; }
        grid = cus * per_cu;
        if (grid > 256) grid = 256;
    }
    if (grid < 0) return;
    Args a{};
    for (int i = 0; i < 22; ++i) a.in[i] = (const float*)d_in[i];
    a.out = (float*)d_out; a.ws = (unsigned char*)d_ws;
#if MK_PER_PHASE
    for (int p = 0; p < NPHASE; ++p) { a.ph_lo = p; a.ph_hi = p + 1; hipLaunchKernelGGL(mk_fwd, dim3(grid), dim3(512), LDS_BYTES, stream, a); }
#else
    a.ph_lo = 0; a.ph_hi = NPHASE;
    void* kargs[] = {&a};
    hipError_t e = hipLaunchCooperativeKernel((const void*)mk_fwd, dim3(grid), dim3(512), kargs, LDS_BYTES, stream);
    if (e != hipSuccess) fprintf(stderr, "cooperative launch failed: %s (grid %d)\n", hipGetErrorString(e), grid);
#endif
}
```

```cpp
#include <hip/hip_runtime.h>
#include <hip/hip_cooperative_groups.h>
#include <cstdio>
#include <cstdint>
namespace cg = cooperative_groups;

#ifndef MK_PER_PHASE
#define MK_PER_PHASE 0
#endif

constexpr int NB = 16, SEQ = 2048, NMETA = 16, DM = 1024, MROWS = NB * SEQ;
constexpr int NH = 8, DH = 64, AW = 512, SW = 512, NG = 32, NP = 64, FF = 2816, FF2 = 5632, INW = 4104;
constexpr int LTOT = SEQ + NMETA;
constexpr float RMS_EPS = 1e-6f;
constexpr float LOG2E = 1.4426950408889634f;
constexpr int NPHASE = 9;
namespace pg8 {
#define PG8_LAS __attribute__((address_space(3)))
typedef unsigned short bf16_t;
typedef short bf16x8 __attribute__((ext_vector_type(8)));
typedef float f32x4 __attribute__((ext_vector_type(4)));
typedef unsigned u32x4 __attribute__((ext_vector_type(4)));
constexpr int BM = 256, BK = 64, HALF = 128, HTB = HALF * BK * 2  , STAGE_BYTES = 8 * HTB, NXCD = 8, WGM = 8;

__host__ __device__ __forceinline__ int lds_byte(int r, int c) { const int st = (r >> 4) * 2 + (c >> 5), rr = r & 15, cc = c & 31, ob = rr * 64 + cc * 2; return st * 1024 + (ob ^ (((ob >> 9) & 1) << 5)); }
__host__ __device__ __forceinline__ void stage_rc(int b, int& R, int& C) { const int st = b / 1024, sb = b % 1024, swz = sb ^ (((sb >> 9) & 1) << 5); R = (st >> 1) * 16 + swz / 64; C = (st & 1) * 32 + (swz % 64) / 2; }
__host__ __device__ __forceinline__ int perm32(int rho) { const int n = rho >> 4, i = rho & 15; return 8 * (i >> 2) + 4 * n + (i & 3); }

struct Unit { int pm, pn; };
struct Gemm { const bf16_t* A; const bf16_t* Bt; int M, N, K; };

struct StaticOrder {
    int nM, nN, nwg, G, c;
    __host__ __device__ void init(int M, int N, int G_, int c_) { nM = M / BM; nN = N / BM; nwg = nM * nN; G = G_; c = c_; }
    __host__ __device__ bool next(int i, Unit& u) const {
        const long L = (long)i * G + c; if (L >= nwg) return false;
        int wgid = (int)L; { const int q = nwg / NXCD, r = nwg % NXCD, xcd = wgid % NXCD, off = wgid / NXCD; wgid = (xcd < r ? xcd * (q + 1) : r * (q + 1) + (xcd - r) * q) + off; }
        const int nig = WGM * nN, gid = wgid / nig, fm = gid * WGM, gsz = (nM - fm) < WGM ? (nM - fm) : WGM;
        u.pm = fm + ((wgid % nig) % gsz); u.pn = (wgid % nig) / gsz; return true;
    }
    __device__ __forceinline__ void a_ready(const Unit&) const {}
    __device__ __forceinline__ void done(const Unit&) const {}
};

__device__ __forceinline__ unsigned cvt_pk_bf16(float lo, float hi) { unsigned r; asm volatile("v_cvt_pk_bf16_f32 %0, %1, %2" : "=v"(r) : "v"(lo), "v"(hi)); return r; }
typedef float f32x2 __attribute__((ext_vector_type(2)));
typedef unsigned u32x4e __attribute__((ext_vector_type(4)));
typedef unsigned u32x2e __attribute__((ext_vector_type(2)));
__device__ __forceinline__ float fsig(float x) { return __builtin_amdgcn_rcpf(1.0f + __builtin_amdgcn_exp2f(-1.4426950408889634f * x)); }
__device__ __forceinline__ float bf_lo(unsigned w) { return __uint_as_float(w << 16); }
__device__ __forceinline__ float bf_hi(unsigned w) { return __uint_as_float(w & 0xffff0000u); }

struct EpiProj {
    static constexpr bool PERM = true, AFTER_DRAIN = false;
    bf16_t* QKVU; bf16_t* GATE;
    __device__ __forceinline__ void operator()(const f32x4 (&acc)[2][2][4][2], const Unit& u, int wr, int wc, int fr, int fq) const {
        const int row0 = u.pm * BM + wr * 64 + fr;
        const bool isg = u.pn >= 8;
        bf16_t* base; int ldc, colt;
        if (!isg) { base = QKVU + (size_t)(u.pn >> 1) * ((size_t)32768 * 512); ldc = 512; colt = (u.pn & 1) * 256; }
        else { base = GATE; ldc = 2048; colt = (u.pn - 8) * 256; }
        const int col0 = colt + wc * 32 + 8 * fq;
#pragma unroll
        for (int ai = 0; ai < 2; ++ai)
#pragma unroll
            for (int m = 0; m < 4; ++m) { bf16_t* rowp = base + (size_t)(row0 + ai * HALF + m * 16) * ldc + col0;
#pragma unroll
                for (int bj = 0; bj < 2; ++bj) { f32x4 v0 = acc[ai][bj][m][0], v1 = acc[ai][bj][m][1];
                    if (isg) { v0 = (f32x4){fsig(v0[0]), fsig(v0[1]), fsig(v0[2]), fsig(v0[3])}; v1 = (f32x4){fsig(v1[0]), fsig(v1[1]), fsig(v1[2]), fsig(v1[3])}; }
                    u32x4e w; w.x = cvt_pk_bf16(v0[0], v0[1]); w.y = cvt_pk_bf16(v0[2], v0[3]); w.z = cvt_pk_bf16(v1[0], v1[1]); w.w = cvt_pk_bf16(v1[2], v1[3]);
                    *(u32x4e*)(rowp + bj * HALF) = w; } }
    }
};

struct EpiYa {
    static constexpr bool PERM = true, AFTER_DRAIN = false;
    const bf16_t* GATE; float* PART;
    __device__ __forceinline__ void operator()(const f32x4 (&acc)[2][2][4][2], const Unit& u, int wr, int wc, int fr, int fq) const {
        const int row0 = u.pm * BM + wr * 64 + fr, col0 = u.pn * BM + wc * 32 + 8 * fq;
#pragma unroll
        for (int ai = 0; ai < 2; ++ai)
#pragma unroll
            for (int m = 0; m < 4; ++m) { const size_t row = (size_t)(row0 + ai * HALF + m * 16);
#pragma unroll
                for (int bj = 0; bj < 2; ++bj) { const int col = col0 + bj * HALF;
                    const u32x4e g = *(const u32x4e*)(GATE + row * 2048 + col);
                    f32x4 v0 = acc[ai][bj][m][0], v1 = acc[ai][bj][m][1];
                    v0 = v0 * (f32x4){bf_lo(g.x), bf_hi(g.x), bf_lo(g.y), bf_hi(g.y)}; v1 = v1 * (f32x4){bf_lo(g.z), bf_hi(g.z), bf_lo(g.w), bf_hi(g.w)};
                    float* p = PART + row * 1024 + col; *(f32x4*)p = v0; *(f32x4*)(p + 4) = v1; } }
    }
};

struct EpiGlu {
    static constexpr bool PERM = true, AFTER_DRAIN = false;
    const bf16_t* GATE; const float* PART; bf16_t* MERGED;
    __device__ __forceinline__ void operator()(const f32x4 (&acc)[2][2][4][2], const Unit& u, int wr, int wc, int fr, int fq) const {
        const int row0 = u.pm * BM + wr * 64 + fr, col = u.pn * HALF + wc * 32 + 8 * fq;
#pragma unroll
        for (int ai = 0; ai < 2; ++ai)
#pragma unroll
            for (int m = 0; m < 4; ++m) { const size_t row = (size_t)(row0 + ai * HALF + m * 16);
                const u32x4e g = *(const u32x4e*)(GATE + row * 2048 + 1024 + col);
                const float* p = PART + row * 1024 + col; const f32x4 p0 = *(const f32x4*)p, p1 = *(const f32x4*)(p + 4);
                const f32x4 a0 = acc[ai][0][m][0], a1 = acc[ai][0][m][1], b0 = acc[ai][1][m][0], b1 = acc[ai][1][m][1];
                f32x4 y0 = (f32x4){a0[0] * fsig(b0[0]), a0[1] * fsig(b0[1]), a0[2] * fsig(b0[2]), a0[3] * fsig(b0[3])};
                f32x4 y1 = (f32x4){a1[0] * fsig(b1[0]), a1[1] * fsig(b1[1]), a1[2] * fsig(b1[2]), a1[3] * fsig(b1[3])};
                y0 = p0 + y0 * (f32x4){bf_lo(g.x), bf_hi(g.x), bf_lo(g.y), bf_hi(g.y)}; y1 = p1 + y1 * (f32x4){bf_lo(g.z), bf_hi(g.z), bf_lo(g.w), bf_hi(g.w)};
                u32x4e w; w.x = cvt_pk_bf16(y0[0], y0[1]); w.y = cvt_pk_bf16(y0[2], y0[3]); w.z = cvt_pk_bf16(y1[0], y1[1]); w.w = cvt_pk_bf16(y1[2], y1[3]);
                *(u32x4e*)(MERGED + row * 1024 + col) = w; }
    }
};

template <bool WITH_BF> struct EpiRes {
    static constexpr bool PERM = true, AFTER_DRAIN = false;
    const float* base; float* out; bf16_t* OB; float* rowss;
    __device__ __forceinline__ void operator()(const f32x4 (&acc)[2][2][4][2], const Unit& u, int wr, int wc, int fr, int fq) const {
        const int row0 = u.pm * BM + wr * 64 + fr, col0 = u.pn * BM + wc * 32 + 8 * fq;
#pragma unroll
        for (int ai = 0; ai < 2; ++ai)
#pragma unroll
            for (int m = 0; m < 4; ++m) { const size_t row = (size_t)(row0 + ai * HALF + m * 16); float ss = 0.f;
#pragma unroll
                for (int bj = 0; bj < 2; ++bj) { const size_t off = row * 1024 + col0 + bj * HALF;
                    const f32x4 r0 = *(const f32x4*)(base + off), r1 = *(const f32x4*)(base + off + 4);
                    const f32x4 v0 = acc[ai][bj][m][0] + r0, v1 = acc[ai][bj][m][1] + r1;
                    *(f32x4*)(out + off) = v0; *(f32x4*)(out + off + 4) = v1;
                    ss += (v0[0] * v0[0] + v0[1] * v0[1]) + (v0[2] * v0[2] + v0[3] * v0[3]) + (v1[0] * v1[0] + v1[1] * v1[1]) + (v1[2] * v1[2] + v1[3] * v1[3]);
                    if (WITH_BF) { u32x4e w; w.x = cvt_pk_bf16(v0[0], v0[1]); w.y = cvt_pk_bf16(v0[2], v0[3]); w.z = cvt_pk_bf16(v1[0], v1[1]); w.w = cvt_pk_bf16(v1[2], v1[3]);
                        *(u32x4e*)(OB + off) = w; } }
                ss += __shfl_xor(ss, 16); ss += __shfl_xor(ss, 32);
                if (fq == 0) atomicAdd(rowss + row, ss); }
    }
};

struct EpiUp {
    static constexpr bool PERM = true, AFTER_DRAIN = false;
    const float* rowss; const float* CP; bf16_t* ACT; float* EDGE;
    __device__ __forceinline__ void operator()(const f32x4 (&acc)[2][2][4][2], const Unit& u, int wr, int wc, int fr, int fq) const {
        const int lane = fq * 16 + fr;
        const int ch0 = u.pn * HALF + wc * 32 + 8 * fq;
        const int idx1 = ((lane & ~15) | ((fr - 1) & 15)) << 2, idx2 = ((lane & ~15) | ((fr - 2) & 15)) << 2;
        const bool s15 = fr == 15, s14 = fr >= 14;
        const bool edge = fr < 2 || fr >= 14; const int slot = fr < 2 ? fr : fr - 12;
        const unsigned cpo = (unsigned)ch0 * 32u;
#pragma unroll
        for (int ai = 0; ai < 2; ++ai) {
            const int rowb = u.pm * BM + ai * HALF + wr * 64;
            const unsigned rso = (unsigned)(rowb + fr) * 4u;
            float rs[4];
#pragma unroll
            for (int m = 0; m < 4; ++m) rs[m] = rsqrtf(*(const float*)((const char*)rowss + rso + m * 64) * (1.0f / 1024.0f) + 1e-6f);
            const unsigned ebo = ((unsigned)(rowb >> 6) * 2816u + (unsigned)ch0) * 32u + (unsigned)slot * 4u;
            const unsigned aco = ((unsigned)(rowb + fr) * 2816u + (unsigned)ch0) * 2u;
#pragma unroll
            for (int n = 0; n < 2; ++n) {
                float ov[4][4];
#pragma unroll
                for (int e = 0; e < 4; ++e) {
                    const f32x4 wv = *(const f32x4*)((const char*)CP + cpo + (4 * n + e) * 32), wg = *(const f32x4*)((const char*)CP + cpo + (4 * n + e) * 32 + 16);
                    float hv[4], hg[4];
#pragma unroll
                    for (int m = 0; m < 4; ++m) { hv[m] = acc[ai][0][m][n][e] * rs[m]; hg[m] = acc[ai][1][m][n][e] * rs[m]; }
                    if (edge) { const float ev = fr < 2 ? hv[0] : hv[3], eg = fr < 2 ? hg[0] : hg[3];
                        *(float*)((char*)EDGE + ebo + (4 * n + e) * 32) = ev; *(float*)((char*)EDGE + ebo + (4 * n + e) * 32 + 16) = eg; }
#pragma unroll
                    for (int m = 0; m < 4; ++m) {
                        const float pv = m > 0 ? hv[m - 1] : 0.f, pg = m > 0 ? hg[m - 1] : 0.f;
                        const float v1 = __int_as_float(__builtin_amdgcn_ds_bpermute(idx1, __float_as_int(s15 ? pv : hv[m])));
                        const float v2 = __int_as_float(__builtin_amdgcn_ds_bpermute(idx2, __float_as_int(s14 ? pv : hv[m])));
                        const float g1 = __int_as_float(__builtin_amdgcn_ds_bpermute(idx1, __float_as_int(s15 ? pg : hg[m])));
                        const float g2 = __int_as_float(__builtin_amdgcn_ds_bpermute(idx2, __float_as_int(s14 ? pg : hg[m])));
                        const float o1 = wv[3] + wv[0] * v2 + wv[1] * v1 + wv[2] * hv[m];
                        const float og = wg[3] + wg[0] * g2 + wg[1] * g1 + wg[2] * hg[m];
                        ov[m][e] = og * fsig(og) * o1;
                    }
                }
#pragma unroll
                for (int m = 0; m < 4; ++m) { u32x2e w; w.x = cvt_pk_bf16(ov[m][0], ov[m][1]); w.y = cvt_pk_bf16(ov[m][2], ov[m][3]);
                    *(u32x2e*)((char*)ACT + aco + (unsigned)(m * 16 * 2816 * 2) + n * 8) = w; }
                asm volatile("" ::: "memory");
            }
        }
    }
};

struct PairOrder {
    int G, c, per;
    __device__ bool next(int i, Unit& u) const { const int su = (i / per) * G + c; if (su >= 256) return false; u.pm = su >> 1; u.pn = (su & 1) * per + (i % per); return true; }
    __device__ __forceinline__ void a_ready(const Unit&) const {}
    __device__ __forceinline__ void done(const Unit&) const {}
};

template <class Epi, class Sched, bool ALIGN_EPI = false, bool SP2 = false>
__device__ __forceinline__ void gemm_phase(PG8_LAS unsigned char* lds, const Gemm g, const Sched& S, const Epi& E) {
    const int tid = threadIdx.x, wid = __builtin_amdgcn_readfirstlane(tid >> 6), lane = tid & 63, wr = wid >> 2, wc = wid & 3, fr = lane & 15, fq = lane >> 4;
    const int K = g.K, nt = K / BK;
    unsigned voffA[2], voffB[2];
#pragma unroll
    for (int i = 0; i < 2; ++i) { int R, C; stage_rc(tid * 16 + i * 8192, R, C); const int Rb = Epi::PERM ? ((R & ~31) + perm32(R & 31)) : R;
        voffA[i] = (unsigned)(R * K + C) * 2u; voffB[i] = (unsigned)(Rb * K + C) * 2u; }
    const size_t kstep = (size_t)(BK * 2);
    const size_t hstep = (size_t)HALF * K * 2;
    const size_t tstep = 2 * hstep;
    const unsigned ldsw = (unsigned)wid * 1024u;
    const int aoff = lds_byte(wr * 64 + fr, fq * 8), boff = lds_byte(wc * 32 + fr, fq * 8);
#define PG8_SA(b, h) (((b) * 2 + (h)) * HTB)
#define PG8_SB(b, h) ((4 + (b) * 2 + (h)) * HTB)
#define PG8_STAGE(bufoff, gbase, voff) do { _Pragma("unroll") for (int _i = 0; _i < 2; ++_i) \
        __builtin_amdgcn_global_load_lds((const unsigned*)((const char*)(gbase) + (voff)[_i]), (PG8_LAS unsigned*)(lds + (bufoff) + ldsw + _i * 8192), 16, 0, 0); } while (0)
#define PG8_LDA(dst, b, h) do { _Pragma("unroll") for (int m = 0; m < 4; ++m) _Pragma("unroll") for (int k = 0; k < 2; ++k) dst[m][k] = *(const PG8_LAS bf16x8*)(lds + PG8_SA(b, h) + aoff + m * 2048 + k * 1024); } while (0)
#define PG8_LDB(dst, b, h) do { _Pragma("unroll") for (int n = 0; n < 2; ++n) _Pragma("unroll") for (int k = 0; k < 2; ++k) dst[n][k] = *(const PG8_LAS bf16x8*)(lds + PG8_SB(b, h) + boff + n * 2048 + k * 1024); } while (0)
#define PG8_MMA(ai, bj, At, Bt) do { __builtin_amdgcn_s_setprio(1); _Pragma("unroll") for (int m = 0; m < 4; ++m) _Pragma("unroll") for (int n = 0; n < 2; ++n) _Pragma("unroll") for (int k = 0; k < 2; ++k) \
        acc[ai][bj][m][n] = __builtin_amdgcn_mfma_f32_16x16x32_bf16(Bt[n][k], At[m][k], acc[ai][bj][m][n], 0, 0, 0); __builtin_amdgcn_s_setprio(0); } while (0)
#define PG8_WAIT_V(n) asm volatile("s_waitcnt vmcnt(" #n ")" ::: "memory")
#define PG8_WAIT_L(n) asm volatile("s_waitcnt lgkmcnt(" #n ")" ::: "memory")
#define PG8_BAR __builtin_amdgcn_s_barrier()
#define PG8_SCHED __builtin_amdgcn_sched_barrier(0)
    Unit cur, nxt; int ui = 0;
    if (!S.next(0, cur)) return;
    f32x4 acc[2][2][4][2];
#pragma unroll
    for (int a = 0; a < 2; ++a)
#pragma unroll
        for (int b = 0; b < 2; ++b)
#pragma unroll
            for (int m = 0; m < 4; ++m)
#pragma unroll
                for (int n = 0; n < 2; ++n) acc[a][b][m][n] = (f32x4){0.f, 0.f, 0.f, 0.f};
    bf16x8 At[4][2], B0[2][2], B1[2][2];
    const char* cA = (const char*)g.A + (size_t)cur.pm * tstep; const char* cB = (const char*)g.Bt + (size_t)cur.pn * tstep;
    S.a_ready(cur);
    if constexpr (SP2) {
        PG8_STAGE(PG8_SB(0, 0), cB, voffB); PG8_STAGE(PG8_SB(0, 1), cB + hstep, voffB); PG8_STAGE(PG8_SA(0, 0), cA, voffA); PG8_STAGE(PG8_SA(0, 1), cA + hstep, voffA);
        if (wr == 1) PG8_BAR;
        PG8_WAIT_V(2); PG8_BAR;
        PG8_STAGE(PG8_SB(1, 0), cB + kstep, voffB); PG8_STAGE(PG8_SA(1, 0), cA + kstep, voffA); PG8_STAGE(PG8_SB(1, 1), cB + hstep + kstep, voffB);
        PG8_WAIT_V(6); PG8_BAR;
    } else {
        PG8_STAGE(PG8_SB(0, 0), cB, voffB); PG8_STAGE(PG8_SA(0, 0), cA, voffA); PG8_STAGE(PG8_SB(0, 1), cB + hstep, voffB); PG8_STAGE(PG8_SA(0, 1), cA + hstep, voffA);
        if (wr == 1) PG8_BAR;
        PG8_WAIT_V(4); PG8_BAR;
        PG8_STAGE(PG8_SB(1, 0), cB + kstep, voffB); PG8_STAGE(PG8_SA(1, 0), cA + kstep, voffA); PG8_STAGE(PG8_SB(1, 1), cB + hstep + kstep, voffB);
        PG8_WAIT_V(6); PG8_BAR;
    }
    for (;;) {
        const bool has_next = S.next(ui + 1, nxt);
        const char* nA = has_next ? (const char*)g.A + (size_t)nxt.pm * tstep : cA; const char* nB = has_next ? (const char*)g.Bt + (size_t)nxt.pn * tstep : cB;
        for (int t = 0; t < nt; t += 2) {
            const bool last = (t == nt - 2);
            const char* a1 = cA + (size_t)(t + 1) * kstep;
            const char* a2 = last ? nA : cA + (size_t)(t + 2) * kstep; const char* b2 = last ? nB : cB + (size_t)(t + 2) * kstep;
            const char* a3 = a2 + kstep; const char* b3 = b2 + kstep;
            if (last && has_next) S.a_ready(nxt);
            if constexpr (SP2) {
            PG8_LDB(B0, 0, 0); PG8_LDB(B1, 0, 1); PG8_SCHED; PG8_LDA(At, 0, 0); PG8_STAGE(PG8_SA(1, 1), a1 + hstep, voffA);
            PG8_WAIT_V(8); PG8_WAIT_L(0); PG8_BAR; PG8_MMA(0, 0, At, B0); PG8_MMA(0, 1, At, B1); PG8_BAR; PG8_SCHED;
            PG8_LDA(At, 0, 1); PG8_STAGE(PG8_SB(0, 0), b2, voffB); PG8_STAGE(PG8_SB(0, 1), b2 + hstep, voffB); PG8_STAGE(PG8_SA(0, 0), a2, voffA);
            PG8_WAIT_V(8); PG8_WAIT_L(0); PG8_BAR; PG8_MMA(1, 0, At, B0); PG8_MMA(1, 1, At, B1); PG8_BAR; PG8_SCHED;
            PG8_LDB(B0, 1, 0); PG8_LDB(B1, 1, 1); PG8_SCHED; PG8_LDA(At, 1, 0); PG8_STAGE(PG8_SA(0, 1), a2 + hstep, voffA);
            PG8_WAIT_V(8); PG8_WAIT_L(0); PG8_BAR; PG8_MMA(0, 0, At, B0); PG8_MMA(0, 1, At, B1); PG8_BAR; PG8_SCHED;
            PG8_LDA(At, 1, 1); PG8_STAGE(PG8_SB(1, 0), b3, voffB); PG8_STAGE(PG8_SB(1, 1), b3 + hstep, voffB); PG8_STAGE(PG8_SA(1, 0), a3, voffA);
            PG8_WAIT_V(8); PG8_WAIT_L(0); PG8_BAR; PG8_MMA(1, 0, At, B0); PG8_MMA(1, 1, At, B1); PG8_BAR; PG8_SCHED;
            } else {
            PG8_LDB(B0, 0, 0); PG8_SCHED; PG8_LDA(At, 0, 0); PG8_STAGE(PG8_SA(1, 1), a1 + hstep, voffA);
            PG8_WAIT_L(8); PG8_BAR; PG8_WAIT_L(0); PG8_MMA(0, 0, At, B0); PG8_BAR; PG8_SCHED;
            PG8_LDB(B1, 0, 1); PG8_STAGE(PG8_SB(0, 0), b2, voffB);
            PG8_BAR; PG8_WAIT_L(0); PG8_MMA(0, 1, At, B1); PG8_BAR;
            PG8_LDA(At, 0, 1); PG8_STAGE(PG8_SA(0, 0), a2, voffA);
            PG8_BAR; PG8_WAIT_L(0); PG8_MMA(1, 0, At, B0); PG8_BAR; PG8_SCHED;
            PG8_STAGE(PG8_SB(0, 1), b2 + hstep, voffB);
            PG8_WAIT_V(6); PG8_BAR; PG8_MMA(1, 1, At, B1); PG8_BAR;
            PG8_LDB(B0, 1, 0); PG8_SCHED; PG8_LDA(At, 1, 0); PG8_STAGE(PG8_SA(0, 1), a2 + hstep, voffA);
            PG8_WAIT_L(8); PG8_BAR; PG8_WAIT_L(0); PG8_MMA(0, 0, At, B0); PG8_BAR; PG8_SCHED;
            PG8_LDB(B1, 1, 1); PG8_STAGE(PG8_SB(1, 0), b3, voffB);
            PG8_BAR; PG8_WAIT_L(0); PG8_MMA(0, 1, At, B1); PG8_BAR;
            PG8_LDA(At, 1, 1); PG8_STAGE(PG8_SA(1, 0), a3, voffA);
            PG8_BAR; PG8_WAIT_L(0); PG8_MMA(1, 0, At, B0); PG8_BAR; PG8_SCHED;
            PG8_STAGE(PG8_SB(1, 1), b3 + hstep, voffB);
            PG8_WAIT_V(6); PG8_BAR; PG8_MMA(1, 1, At, B1); PG8_BAR;
            }
        }
        if constexpr (ALIGN_EPI) { if (wr == 0) PG8_BAR; }
        if constexpr (!Epi::AFTER_DRAIN) { E(acc, cur, wr, wc, fr, fq); S.done(cur); }
        if (!has_next) break;
#pragma unroll
        for (int a = 0; a < 2; ++a)
#pragma unroll
            for (int b = 0; b < 2; ++b)
#pragma unroll
                for (int m = 0; m < 4; ++m)
#pragma unroll
                    for (int n = 0; n < 2; ++n) acc[a][b][m][n] = (f32x4){0.f, 0.f, 0.f, 0.f};
        cur = nxt; cA = nA; cB = nB; ++ui;
        if constexpr (ALIGN_EPI) { if (wr == 1) PG8_BAR; }
    }
    PG8_WAIT_V(0);
    if constexpr (!ALIGN_EPI) { if (wr == 0) PG8_BAR; }
    PG8_BAR;
    if constexpr (Epi::AFTER_DRAIN) { E.fused(acc, cur, wr, wc, fr, fq, lds, wid, lane); S.done(cur); }
#undef PG8_SA
#undef PG8_SB
#undef PG8_STAGE
#undef PG8_LDA
#undef PG8_LDB
#undef PG8_MMA
#undef PG8_WAIT_V
#undef PG8_WAIT_L
#undef PG8_BAR
#undef PG8_SCHED
}
}

#define LAS __attribute__((address_space(3)))
typedef unsigned short bf16;
typedef short bf16x8 __attribute__((ext_vector_type(8)));
typedef float f32x4 __attribute__((ext_vector_type(4)));
typedef float f32x16 __attribute__((ext_vector_type(16)));
typedef unsigned v4u __attribute__((ext_vector_type(4)));
typedef unsigned v2u __attribute__((ext_vector_type(2)));
typedef float f32x2v __attribute__((ext_vector_type(2)));
typedef __bf16 bf16x2n __attribute__((ext_vector_type(2)));
#define LDS_WAIT() asm volatile("s_waitcnt lgkmcnt(0)" ::: "memory")
__device__ __forceinline__ unsigned pk2(float lo, float hi) { f32x2v v = {lo, hi}; return __builtin_bit_cast(unsigned, __builtin_convertvector(v, bf16x2n)); }
__device__ __forceinline__ float bf2f(bf16 h) { return __uint_as_float((unsigned)h << 16); }
__device__ __forceinline__ float blo(unsigned w) { return __uint_as_float(w << 16); }
__device__ __forceinline__ float bhi(unsigned w) { return __uint_as_float(w & 0xffff0000u); }
__device__ __forceinline__ float fsigm(float x) { return __builtin_amdgcn_rcpf(1.0f + __builtin_amdgcn_exp2f(-LOG2E * x)); }
__device__ __forceinline__ float wave_sum(float v) {
#pragma unroll
    for (int o = 1; o < 64; o <<= 1) v += __shfl_xor(v, o);
    return v;
}

constexpr size_t MiB = 1u << 20;
constexpr size_t WS_ROWSS1 = 0, WS_ROWSS2 = 128 * 1024;
constexpr size_t WS_LOGFM = 256 * 1024;
constexpr size_t WS_XNM = 1 * MiB;
constexpr size_t WS_QKVUM = WS_XNM + 64 * 1024;
constexpr size_t WS_GATEM = WS_QKVUM + 64 * 1024;
constexpr size_t WS_AA = WS_GATEM + 64 * 1024, WS_ZA = WS_AA + 16 * 1024;
constexpr size_t WS_MA = WS_ZA + 16 * 1024, WS_HA = WS_MA + 32 * 1024;
constexpr size_t WS_EDGEM = WS_HA + 32 * 1024;
constexpr size_t WS_CP = WS_EDGEM + 64 * 1024;
constexpr size_t WS_LOGF = 2 * MiB;
constexpr size_t WS_CUMF = 3 * MiB;
constexpr size_t WS_WIN = 6 * MiB, WS_WA = 14 * MiB, WS_WG = 15 * MiB, WS_WO = 17 * MiB, WS_WUP = 19 * MiB, WS_WDN = 30 * MiB;
constexpr size_t WS_RA = 36 * MiB;
constexpr size_t WS_RB = 100 * MiB;
constexpr size_t WS_QKVU = 164 * MiB;
constexpr size_t WS_GATE = 292 * MiB;
constexpr size_t WS_ACT = 164 * MiB;
constexpr size_t WS_EDGE = 420 * MiB;
constexpr size_t WS_END = 464 * MiB;
constexpr int LDS_BYTES = 135168;

struct Args { const float* in[22]; float* out; unsigned char* ws; int ph_lo, ph_hi; };

struct Frame {
    LAS unsigned char* lds; unsigned char* ws; const float* const* in; float* out;
    int tid, lane, wave, vcu, G;
};

__device__ __forceinline__ void tr_item(const float* W, int K, int Nsrc, bf16* WT, int src_col0, int dst_row0, int k0, const float* gk, LAS float* scr, int lane) {
#pragma unroll 8
    for (int i = 0; i < 32; ++i) { const int kk = 2 * i + (lane >> 5); float v = W[(size_t)(k0 + kk) * Nsrc + src_col0 + (lane & 31)]; if (gk) v *= gk[k0 + kk]; scr[kk * 33 + (lane & 31)] = v; }
    LDS_WAIT(); asm volatile("" ::: "memory");
    const int c = lane & 7;
#pragma unroll
    for (int j = 0; j < 4; ++j) { const int n = (lane >> 3) + 8 * j; const LAS float* s = scr + (8 * c) * 33 + n;
        v4u o; o.x = pk2(s[0 * 33], s[1 * 33]); o.y = pk2(s[2 * 33], s[3 * 33]); o.z = pk2(s[4 * 33], s[5 * 33]); o.w = pk2(s[6 * 33], s[7 * 33]);
        *(v4u*)(WT + (size_t)(dst_row0 + n) * K + k0 + 8 * c) = o; }
    LDS_WAIT(); asm volatile("" ::: "memory");
}
__device__ __forceinline__ float log_sigmoid(float x) { return x >= 0.f ? -log1pf(expf(-x)) : x - log1pf(expf(x)); }

__device__ __forceinline__ void norm_row(const float* xrow, const f32x4 (&gv)[4], bf16* orow, const LAS float* wf, const float* bfg, float* lf, int lane) {
    const f32x4* xr = (const f32x4*)xrow + lane;
    f32x4 v[4]; float s = 0.f;
#pragma unroll
    for (int j = 0; j < 4; ++j) { v[j] = xr[64 * j]; s += (v[j].x * v[j].x + v[j].y * v[j].y) + (v[j].z * v[j].z + v[j].w * v[j].w); }
    const float rstd = rsqrtf(wave_sum(s) * (1.f / DM) + RMS_EPS);
    float fa[8];
#pragma unroll
    for (int q = 0; q < 8; ++q) fa[q] = 0.f;
    unsigned long long* o8 = (unsigned long long*)orow + lane;
#pragma unroll
    for (int j = 0; j < 4; ++j) { v[j] = v[j] * rstd * gv[j];
        o8[64 * j] = (unsigned long long)pk2(v[j].x, v[j].y) | ((unsigned long long)pk2(v[j].z, v[j].w) << 32);
#pragma unroll
        for (int e = 0; e < 4; ++e) { const LAS f32x4* wp = (const LAS f32x4*)(wf + (size_t)(256 * j + 4 * lane + e) * 8); const f32x4 w0 = wp[0], w1 = wp[1]; const float xv = v[j][e];
            fa[0] += xv * w0.x; fa[1] += xv * w0.y; fa[2] += xv * w0.z; fa[3] += xv * w0.w; fa[4] += xv * w1.x; fa[5] += xv * w1.y; fa[6] += xv * w1.z; fa[7] += xv * w1.w; } }
    float mine = 0.f;
#pragma unroll
    for (int q = 0; q < 8; ++q) { const float t = wave_sum(fa[q]); if (lane == q) mine = t; }
    if (lane < 8) lf[lane] = log_sigmoid(mine + bfg[lane]);
}

__device__ __forceinline__ void p0_prologue(Frame& F) {
    const int gw = F.vcu * 8 + F.wave, NGW = F.G * 8, lane = F.lane;
    const float* const* in = F.in;
    { float* z = (float*)(F.ws + WS_ROWSS1); for (int i = blockIdx.x * 512 + F.tid; i < 2 * 32768; i += F.G * 512) z[i] = 0.f; }
    { float* cp = (float*)(F.ws + WS_CP); for (int i = blockIdx.x * 512 + F.tid; i < FF * 8; i += F.G * 512) { const int c = i >> 3, k = i & 7, cc = c + (k >= 4 ? FF : 0), kk = k & 3; cp[i] = kk < 3 ? in[18][kk * FF2 + cc] : in[19][cc]; } }
    LAS float* wf = (LAS float*)(F.lds);
    for (int i = F.tid; i < 1024 * 8; i += 512) wf[i] = in[3][(size_t)(i >> 3) * INW + 1536 + (i & 7)];
    __syncthreads();
    LAS float* scr = (LAS float*)(F.lds + 32768 + F.wave * 9216);
    constexpr int I_IN = 16 * 128, I_A = 8 * 32, I_G = 8 * 64, I_O = 16 * 32, I_UP = 16 * 176, I_DN = 44 * 32;
    constexpr int NITEMS = I_IN + I_A + I_G + I_O + I_UP + I_DN;
    for (int it = gw; it < NITEMS; it += NGW) {
        int r = it;
        if (r < I_IN) { const int kb = r / 128, db = r % 128; tr_item(in[3], 1024, INW, (bf16*)(F.ws + WS_WIN), db < 48 ? 32 * db : 1544 + 32 * (db - 48), 32 * db, 64 * kb, nullptr, scr, lane); continue; } r -= I_IN;
        if (r < I_A) { const int kb = r / 32, db = r % 32; tr_item(in[5], 512, 1024, (bf16*)(F.ws + WS_WA), 32 * db, 32 * db, 64 * kb, nullptr, scr, lane); continue; } r -= I_A;
        if (r < I_G) { const int kb = r / 64, db = r % 64, pn = db >> 3, wi = db & 7; tr_item(in[14], 512, 2048, (bf16*)(F.ws + WS_WG), wi < 4 ? 128 * pn + 32 * wi : 1024 + 128 * pn + 32 * (wi - 4), 32 * db, 64 * kb, nullptr, scr, lane); continue; } r -= I_G;
        if (r < I_O) { const int kb = r / 32, db = r % 32; tr_item(in[15], 1024, 1024, (bf16*)(F.ws + WS_WO), 32 * db, 32 * db, 64 * kb, nullptr, scr, lane); continue; } r -= I_O;
        if (r < I_UP) { const int kb = r / 176, db = r % 176, pn = db >> 3, wi = db & 7; tr_item(in[17], 1024, FF2, (bf16*)(F.ws + WS_WUP), wi < 4 ? 128 * pn + 32 * wi : FF + 128 * pn + 32 * (wi - 4), 32 * db, 64 * kb, in[16], scr, lane); continue; } r -= I_UP;
        { const int kb = r / 32, db = r % 32; tr_item(in[20], FF, 1024, (bf16*)(F.ws + WS_WDN), 32 * db, 32 * db, 64 * kb, nullptr, scr, lane); }
    }
    f32x4 gv[4];
#pragma unroll
    for (int j = 0; j < 4; ++j) gv[j] = ((const f32x4*)in[2])[lane + 64 * j];
    bf16* XN = (bf16*)(F.ws + WS_RA); float* LOGF = (float*)(F.ws + WS_LOGF);
    for (int m = gw; m < MROWS + NMETA; m += NGW) {
        if (m < MROWS) norm_row(in[0] + (size_t)m * DM, gv, XN + (size_t)m * DM, wf, in[4], LOGF + (size_t)m * 8, lane);
        else { const int r = m - MROWS; norm_row(in[1] + (size_t)r * DM, gv, (bf16*)(F.ws + WS_XNM) + (size_t)r * DM, wf, in[4], (float*)(F.ws + WS_LOGFM) + r * 8, lane); }
    }
}

__device__ __forceinline__ f32x4 skinny_tile(const bf16* A, const bf16* Bt, int K, int ct, int lane) {
    const bf16* ap = A + (size_t)(lane & 15) * K + 8 * (lane >> 4);
    const bf16* bp = Bt + (size_t)(16 * ct + (lane & 15)) * K + 8 * (lane >> 4);
    f32x4 acc = {0.f, 0.f, 0.f, 0.f};
    for (int s = 0; s < K / 32; s += 16) {
        bf16x8 a[16], b[16];
#pragma unroll
        for (int q = 0; q < 16; ++q) { a[q] = *(const bf16x8*)(ap + 32 * (s + q)); b[q] = *(const bf16x8*)(bp + 32 * (s + q)); }
#pragma unroll
        for (int q = 0; q < 16; ++q) acc = __builtin_amdgcn_mfma_f32_16x16x32_bf16(a[q], b[q], acc, 0, 0, 0);
    }
    return acc;
}
template <int MODE>
__device__ __forceinline__ f32x4 skinny2(const void* X0, const void* X1, const bf16* Bt, int K, int ct, int lane) {
    const int row = lane & 15, ko = 8 * (lane >> 4); const bool live = row < 2;
    const bf16* bp = Bt + (size_t)(16 * ct + row) * K + ko;
    f32x4 acc = {0.f, 0.f, 0.f, 0.f};
    for (int s = 0; s < K / 32; s += 16) {
        bf16x8 a[16], b[16];
#pragma unroll
        for (int q = 0; q < 16; ++q) { b[q] = *(const bf16x8*)(bp + 32 * (s + q));
            v4u w = {0u, 0u, 0u, 0u};
            if (live) { const size_t o = (size_t)row * K + ko + 32 * (s + q);
                if (MODE == 0) w = *(const v4u*)((const bf16*)X0 + o);
                else { f32x4 p0 = *(const f32x4*)((const float*)X0 + o), p1 = *(const f32x4*)((const float*)X0 + o + 4);
                    if (MODE == 1) { p0 = p0 + *(const f32x4*)((const float*)X1 + o); p1 = p1 + *(const f32x4*)((const float*)X1 + o + 4); }
                    w.x = pk2(p0.x, p0.y); w.y = pk2(p0.z, p0.w); w.z = pk2(p1.x, p1.y); w.w = pk2(p1.z, p1.w); } }
            a[q] = __builtin_bit_cast(bf16x8, w); }
#pragma unroll
        for (int q = 0; q < 16; ++q) acc = __builtin_amdgcn_mfma_f32_16x16x32_bf16(a[q], b[q], acc, 0, 0, 0);
    }
    return acc;
}

__device__ __forceinline__ void p1_extras(Frame& F) {
    const int gw = F.vcu * 8 + F.wave, NGW = F.G * 8, lane = F.lane;
    for (int ct = gw; ct < 256; ct += NGW) {
        const f32x4 acc = skinny_tile((const bf16*)(F.ws + WS_XNM), (const bf16*)(F.ws + WS_WIN), 1024, ct, lane);
        const int col = 16 * ct + (lane & 15), fq = lane >> 4;
#pragma unroll
        for (int i = 0; i < 4; ++i) { const int r = 4 * fq + i;
            if (col < 2048) ((bf16*)(F.ws + WS_QKVUM))[(size_t)(col >> 9) * (16 * 512) + r * 512 + (col & 511)] = (bf16)(pk2(acc[i], 0.f) & 0xffffu);
            else ((bf16*)(F.ws + WS_GATEM))[r * 2048 + (col - 2048)] = (bf16)(pk2(fsigm(acc[i]), 0.f) & 0xffffu); }
    }
    const float* LOGF = (const float*)(F.ws + WS_LOGF); const float* LOGFM = (const float*)(F.ws + WS_LOGFM); float* CUMF = (float*)(F.ws + WS_CUMF);
    for (int sq = gw; sq < NB * NH; sq += NGW) { const int b = sq >> 3, h = sq & 7; float carry = 0.f;
        for (int p0 = 0; p0 < LTOT; p0 += 64) { const int p = p0 + lane;
            float v = 0.f; if (p < LTOT) v = p < NMETA ? LOGFM[p * 8 + h] : LOGF[(size_t)(b * SEQ + p - NMETA) * 8 + h];
#pragma unroll
            for (int o = 1; o < 64; o <<= 1) { const float t = __shfl_up(v, o); if (lane >= o) v += t; }
            v += carry; if (p < LTOT) CUMF[(size_t)sq * LTOT + p] = v; carry = __shfl(v, 63); } }
}

struct S5Regs { float l0r, l0i, l1r, l1i; bf16x8 Bf[4]; bf16x8 Cm[4]; float dsk; };
__device__ __forceinline__ void cw_sincos(float x, float& s, float& c) { s = sinf(x); c = cosf(x); }
__device__ __forceinline__ void s5_setup(const float* const* in, int g, int lane, S5Regs& R) {
    const int j = lane & 31, kq5 = lane >> 5;
    const float dt = expf(in[13][g]);
#pragma unroll
    for (int wh = 0; wh < 2; ++wh) { const int p = j + 32 * wh;
        const float lr = in[6][g * 64 + p], li = in[7][g * 64 + p];
        const float a = lr * dt, b = li * dt, ea = expf(a); float sb, cb; cw_sincos(b, sb, cb);
        const float lbr = ea * cb, lbi = ea * sb;
        const float sh = sinf(0.5f * b), nre = expm1f(a) * cb - 2.f * sh * sh, nim = ea * sb;
        const float den = 1.0f / (lr * lr + li * li), cre = (nre * lr + nim * li) * den, cim = (nim * lr - nre * li) * den;
        const f32x4* br = (const f32x4*)(in[8] + ((size_t)(g * 64 + p) * 16 + 8 * kq5)); const f32x4* bi = (const f32x4*)(in[9] + ((size_t)(g * 64 + p) * 16 + 8 * kq5));
        const f32x4 r0 = br[0], r1 = br[1], i0 = bi[0], i1 = bi[1];
        v4u re, im;
        re.x = pk2(cre * r0.x - cim * i0.x, cre * r0.y - cim * i0.y); re.y = pk2(cre * r0.z - cim * i0.z, cre * r0.w - cim * i0.w);
        re.z = pk2(cre * r1.x - cim * i1.x, cre * r1.y - cim * i1.y); re.w = pk2(cre * r1.z - cim * i1.z, cre * r1.w - cim * i1.w);
        im.x = pk2(cre * i0.x + cim * r0.x, cre * i0.y + cim * r0.y); im.y = pk2(cre * i0.z + cim * r0.z, cre * i0.w + cim * r0.w);
        im.z = pk2(cre * i1.x + cim * r1.x, cre * i1.y + cim * r1.y); im.w = pk2(cre * i1.z + cim * r1.z, cre * i1.w + cim * r1.w);
        R.Bf[2 * wh] = __builtin_bit_cast(bf16x8, re); R.Bf[2 * wh + 1] = __builtin_bit_cast(bf16x8, im);
        if (wh == 0) { R.l0r = lbr; R.l0i = lbi; } else { R.l1r = lbr; R.l1i = lbi; } }
    const int c = lane & 15, kq = lane >> 4;
    const float* cr = in[10] + (size_t)(g * 16 + c) * 64; const float* ci = in[11] + (size_t)(g * 16 + c) * 64;
#pragma unroll
    for (int s = 0; s < 4; ++s) { const int ja = 8 * s + 2 * kq, jb = ja + 1; v4u w;
        w.x = pk2(cr[ja], -ci[ja]); w.y = pk2(cr[ja + 32], -ci[ja + 32]); w.z = pk2(cr[jb], -ci[jb]); w.w = pk2(cr[jb + 32], -ci[jb + 32]);
        R.Cm[s] = __builtin_bit_cast(bf16x8, w); }
    R.dsk = in[12][g * 16 + c];
}
constexpr int S5_XP = 136;
template <bool FULL, class ZST>
__device__ __forceinline__ void s5_chunk(const S5Regs& R, const bf16x8 a, float (&x)[4], LAS bf16* X, LAS bf16* Ut, int lane, const ZST& zst) {
    f32x16 bu[4];
    const f32x16 zero = {0.f, 0.f, 0.f, 0.f, 0.f, 0.f, 0.f, 0.f, 0.f, 0.f, 0.f, 0.f, 0.f, 0.f, 0.f, 0.f};
#pragma unroll
    for (int q = 0; q < 4; ++q) bu[q] = __builtin_amdgcn_mfma_f32_32x32x16_bf16(a, R.Bf[q], zero, 0, 0, 0);
    const int j = lane & 31, hi = lane >> 5;
    if (FULL) { const int i = lane & 31, th = (i >> 2) & 1, r = (i & 3) + 4 * (i >> 3); *(LAS bf16x8*)(Ut + (16 * th + r) * 16 + 8 * hi) = a; }
#pragma unroll
    for (int r = 0; r < 16; ++r) {
        const float n0r = fmaf(R.l0r, x[0], fmaf(-R.l0i, x[1], bu[0][r])), n0i = fmaf(R.l0r, x[1], fmaf(R.l0i, x[0], bu[1][r]));
        const float n1r = fmaf(R.l1r, x[2], fmaf(-R.l1i, x[3], bu[2][r])), n1i = fmaf(R.l1r, x[3], fmaf(R.l1i, x[2], bu[3][r]));
        x[0] = n0r; x[1] = n0i; x[2] = n1r; x[3] = n1i;
        if (FULL) { v2u w; w.x = pk2(n0r, n0i); w.y = pk2(n1r, n1i); *(LAS v2u*)(X + (16 * hi + r) * S5_XP + 4 * j) = w; }
    }
    if (FULL) {
        LDS_WAIT(); asm volatile("" ::: "memory");
        const int c = lane & 15, fq = lane >> 4;
#pragma unroll
        for (int th = 0; th < 2; ++th) { f32x4 acc = {0.f, 0.f, 0.f, 0.f};
#pragma unroll
            for (int s = 0; s < 4; ++s) { const bf16x8 xa = *(const LAS bf16x8*)(X + (16 * th + c) * S5_XP + 32 * s + 8 * fq); acc = __builtin_amdgcn_mfma_f32_16x16x32_bf16(xa, R.Cm[s], acc, 0, 0, 0); }
#pragma unroll
            for (int i = 0; i < 4; ++i) { const int r = 4 * fq + i; const float y = acc[i] + R.dsk * bf2f(Ut[(16 * th + r) * 16 + c]);
                const float uu = 0.7978845608028654f * (y + 0.044715f * y * y * y); zst(th, r, c, y * fsigm(2.f * uu)); } }
        LDS_WAIT(); asm volatile("" ::: "memory");
    }
}
struct ZNone { __device__ __forceinline__ void operator()(int, int, int, float) const {} };
struct ZMain { bf16* z0; bf16* z1; __device__ __forceinline__ void operator()(int th, int r, int c, float v) const { (th ? z1 : z0)[(size_t)r * 512 + c] = (bf16)(pk2(v, 0.f) & 0xffffu); } };
struct ZMeta { bf16* za; __device__ __forceinline__ void operator()(int th, int r, int c, float v) const { if (th == 0 && r >= 14) za[(r - 14) * 512 + c] = (bf16)(pk2(v, 0.f) & 0xffffu); } };

__device__ __forceinline__ void s5_unit(Frame& F, int g, int bp) {
    const int lane = F.lane, w = F.wave;
    LAS bf16* X = (LAS bf16*)(F.lds + w * 10240); LAS bf16* Ut = (LAS bf16*)(F.lds + w * 10240 + 8704);
    LAS float* Ex = (LAS float*)(F.lds + 81920);
    S5Regs R; s5_setup(F.in, g, lane, R);
    const bf16* U = (const bf16*)(F.ws + WS_QKVU) + (size_t)3 * MROWS * 512; const bf16* UM = (const bf16*)(F.ws + WS_QKVUM) + 3 * 16 * 512;
    bf16* Z = (bf16*)(F.ws + WS_RB + 32 * MiB);
    const int i = lane & 31, kq5 = lane >> 5, th = (i >> 2) & 1, r = (i & 3) + 4 * (i >> 3);
    const bf16* upm = UM + r * 512 + 16 * g + 8 * kq5;
    const int t0 = 256 * w;
    const bf16* up0 = U + ((size_t)((2 * bp + th) * SEQ + t0 + r)) * 512 + 16 * g + 8 * kq5;
    float x[4] = {0.f, 0.f, 0.f, 0.f}; float xm[4] = {0.f, 0.f, 0.f, 0.f};
    if (w == 0) { s5_chunk<false>(R, *(const bf16x8*)upm, x, X, Ut, lane, ZNone{}); xm[0] = x[0]; xm[1] = x[1]; xm[2] = x[2]; xm[3] = x[3]; }
    { bf16x8 an = *(const bf16x8*)up0;
      for (int c = 0; c < 16; ++c) { const bf16x8 ac = an; if (c < 15) an = *(const bf16x8*)(up0 + (size_t)(c + 1) * 16 * 512); s5_chunk<false>(R, ac, x, X, Ut, lane, ZNone{}); } }
    *(LAS f32x4*)(Ex + (w * 64 + lane) * 4) = (f32x4){x[0], x[1], x[2], x[3]};
    __syncthreads();
    float p0r = R.l0r, p0i = R.l0i, p1r = R.l1r, p1i = R.l1i;
#pragma unroll
    for (int q = 0; q < 8; ++q) { const float a = p0r * p0r - p0i * p0i, b = 2.f * p0r * p0i, c2 = p1r * p1r - p1i * p1i, d = 2.f * p1r * p1i; p0r = a; p0i = b; p1r = c2; p1i = d; }
    if (w == 0) { x[0] = xm[0]; x[1] = xm[1]; x[2] = xm[2]; x[3] = xm[3]; }
    else { f32x4 e = *(const LAS f32x4*)(Ex + lane * 4);
        for (int v = 1; v < w; ++v) { const f32x4 ev = *(const LAS f32x4*)(Ex + (v * 64 + lane) * 4);
            const float a = ev[0] + p0r * e[0] - p0i * e[1], b = ev[1] + p0r * e[1] + p0i * e[0], c2 = ev[2] + p1r * e[2] - p1i * e[3], d = ev[3] + p1r * e[3] + p1i * e[2]; e = (f32x4){a, b, c2, d}; }
        x[0] = e[0]; x[1] = e[1]; x[2] = e[2]; x[3] = e[3]; }
    { bf16x8 an = *(const bf16x8*)up0;
      for (int c = 0; c < 16; ++c) { const int t = t0 + 16 * c; const bf16x8 ac = an; if (c < 15) an = *(const bf16x8*)(up0 + (size_t)(c + 1) * 16 * 512);
        ZMain zs{Z + ((size_t)((2 * bp) * SEQ + t)) * 512 + 16 * g, Z + ((size_t)((2 * bp + 1) * SEQ + t)) * 512 + 16 * g};
        s5_chunk<true>(R, ac, x, X, Ut, lane, zs); } }
    __syncthreads();
}

__device__ __forceinline__ void meta_p2(Frame& F) {
    const int tid = F.tid, lane = F.lane, w = F.wave, gw = F.vcu * 8 + w;
    bf16* aA = (bf16*)(F.ws + WS_AA); bf16* zA = (bf16*)(F.ws + WS_ZA);
    const bf16* QM = (const bf16*)(F.ws + WS_QKVUM); const bf16* KM = QM + 16 * 512; const bf16* VM = KM + 16 * 512; const bf16* UM = VM + 16 * 512;
    const float* LOGFM = (const float*)(F.ws + WS_LOGFM);
    if (gw < NG) { LAS bf16* X = (LAS bf16*)(F.lds + w * 10240); LAS bf16* Ut = (LAS bf16*)(F.lds + w * 10240 + 8704);
        const int i = lane & 31, kq5 = lane >> 5, r = (i & 3) + 4 * (i >> 3), g = gw;
        S5Regs R; s5_setup(F.in, g, lane, R); float x[4] = {0.f, 0.f, 0.f, 0.f};
        s5_chunk<true>(R, *(const bf16x8*)(UM + r * 512 + 16 * g + 8 * kq5), x, X, Ut, lane, ZMeta{zA + 16 * g}); }
    if (F.vcu == (F.G > 4 ? 4 : 0)) {
        LAS float* PM = (LAS float*)(F.lds + 98304);
        __syncthreads();
        if (tid < 256) { const int h = tid >> 5, qi = (tid >> 4) & 1, key = tid & 15, qp = 14 + qi;
            float s = 0.f;
            for (int d = 0; d < 64; ++d) s += bf2f(QM[qp * 512 + 64 * h + d]) * bf2f(KM[key * 512 + 64 * h + d]);
            float fq = 0.f, fk = 0.f;
            for (int p = 0; p < 16; ++p) { const float lf = LOGFM[p * 8 + h]; if (p <= qp) fq += lf; if (p <= key) fk += lf; }
            s = s * 0.125f + fq - fk; if (key > qp) s = -1e30f;
            float mx = s;
#pragma unroll
            for (int o = 1; o < 16; o <<= 1) mx = fmaxf(mx, __shfl_xor(mx, o));
            float p = expf(s - mx), sum = p;
#pragma unroll
            for (int o = 1; o < 16; o <<= 1) sum += __shfl_xor(sum, o);
            PM[(h * 2 + qi) * 16 + key] = p / sum; }
        __syncthreads();
        for (int o = tid; o < 1024; o += 512) { const int qi = o >> 9, col = o & 511, h = col >> 6; float a = 0.f;
            for (int k = 0; k < 16; ++k) a += PM[(h * 2 + qi) * 16 + k] * bf2f(VM[k * 512 + col]);
            aA[qi * 512 + col] = (bf16)(pk2(a, 0.f) & 0xffffu); }
        __syncthreads();
    }
}
__device__ __forceinline__ void meta_p3(Frame& F) {
    const int lane = F.lane, gw = F.vcu * 8 + F.wave;
    const bf16* GM = (const bf16*)(F.ws + WS_GATEM); float* YA = (float*)(F.ws + WS_MA); float* GY = YA + 2048;
    if (gw < 64) { const int ct = gw; const f32x4 acc = skinny2<0>(F.ws + WS_AA, nullptr, (const bf16*)(F.ws + WS_WA), 512, ct, lane);
        if (lane < 16) { const int col = 16 * ct + lane; YA[col] = acc[0] * bf2f(GM[14 * 2048 + col]); YA[1024 + col] = acc[1] * bf2f(GM[15 * 2048 + col]); } }
    else if (gw < 128) { const int pi = gw - 64, pn = pi >> 3, wi = pi & 7;
        const f32x4 av = skinny2<0>(F.ws + WS_ZA, nullptr, (const bf16*)(F.ws + WS_WG), 512, 16 * pn + wi, lane), ag = skinny2<0>(F.ws + WS_ZA, nullptr, (const bf16*)(F.ws + WS_WG), 512, 16 * pn + 8 + wi, lane);
        if (lane < 16) { const int ch = 128 * pn + 16 * wi + lane;
            GY[ch] = bf2f(GM[14 * 2048 + 1024 + ch]) * av[0] * fsigm(ag[0]); GY[1024 + ch] = bf2f(GM[15 * 2048 + 1024 + ch]) * av[1] * fsigm(ag[1]); } }
}
__device__ __forceinline__ void meta_p4(Frame& F) {
    const int lane = F.lane, gw = F.vcu * 8 + F.wave;
    const float* YA = (const float*)(F.ws + WS_MA); float* H1M = (float*)(F.ws + WS_HA);
    if (gw < 64) { const int ct = gw; const f32x4 acc = skinny2<1>(YA, YA + 2048, (const bf16*)(F.ws + WS_WO), 1024, ct, lane);
        if (lane < 16) { const int col = 16 * ct + lane; H1M[col] = F.in[1][14 * 1024 + col] + acc[0]; H1M[1024 + col] = F.in[1][15 * 1024 + col] + acc[1]; } }
}
__device__ __forceinline__ void meta_p5(Frame& F) {
    const int lane = F.lane, gw = F.vcu * 8 + F.wave, NGW = F.G * 8;
    const float* H1M = (const float*)(F.ws + WS_HA); float* EM = (float*)(F.ws + WS_EDGEM);
    for (int ct = gw; ct < 352; ct += NGW) {
        float s0 = 0.f, s1 = 0.f;
#pragma unroll
        for (int q = 0; q < 4; ++q) { const f32x4 a = ((const f32x4*)H1M)[lane + 64 * q], b = ((const f32x4*)(H1M + 1024))[lane + 64 * q];
            s0 += (a.x * a.x + a.y * a.y) + (a.z * a.z + a.w * a.w); s1 += (b.x * b.x + b.y * b.y) + (b.z * b.z + b.w * b.w); }
        const float r0 = rsqrtf(wave_sum(s0) * (1.f / 1024.f) + RMS_EPS), r1 = rsqrtf(wave_sum(s1) * (1.f / 1024.f) + RMS_EPS);
        const f32x4 acc = skinny2<2>(H1M, nullptr, (const bf16*)(F.ws + WS_WUP), 1024, ct, lane);
        if (lane < 16) { const int pn = ct >> 4, wi = ct & 15; const int hc = wi < 8 ? 128 * pn + 16 * wi + lane : FF + 128 * pn + 16 * (wi - 8) + lane;
            EM[hc] = r0 * acc[0]; EM[FF2 + hc] = r1 * acc[1]; } }
}

__device__ __forceinline__ int crow(int r, int hi) { return (r & 3) + 8 * (r >> 2) + 4 * hi; }
constexpr int AT_KP = 72, AT_VP = 68, AT_BUF = 64 * AT_KP * 2 + 64 * AT_VP * 2 + 256;
__device__ __forceinline__ void attn_unit(Frame& F, int b, int h, int qb) {
    const int tid = F.tid, lane = F.lane, w = F.wave, q = lane & 31, hi = lane >> 5;
    const bf16* Q = (const bf16*)(F.ws + WS_QKVU); const bf16* K = Q + (size_t)MROWS * 512; const bf16* V = K + (size_t)MROWS * 512;
    const bf16* KM = (const bf16*)(F.ws + WS_QKVUM) + 16 * 512; const bf16* VM = KM + 16 * 512;
    const float* CF = (const float*)(F.ws + WS_CUMF) + (size_t)(b * 8 + h) * LTOT;
    bf16* ATT = (bf16*)(F.ws + WS_RB);
    const int t0w = 256 * qb + 32 * w, pq = NMETA + t0w + q;
    const size_t rowq = (size_t)b * SEQ + t0w + q;
    bf16x8 Qf[4];
#pragma unroll
    for (int s = 0; s < 4; ++s) Qf[s] = *(const bf16x8*)(Q + rowq * 512 + 64 * h + 16 * s + 8 * hi);
    const float Fq = CF[pq] * LOG2E;
    const int ntiles = 4 * qb + 5, jmax = 4 * qb + ((32 * w + 47) >> 6);
    float mrun = -1e30f, lrun = 0.f;
    f32x16 O0, O1;
#pragma unroll
    for (int r = 0; r < 16; ++r) { O0[r] = 0.f; O1[r] = 0.f; }
    const int skey = tid >> 3, sch = tid & 7;
    v4u kreg, vreg; float fkreg = 0.f;
#define AT_LOAD(jt) do { const int p_ = 64 * (jt) + skey; const bf16 *kp_, *vp_; \
        if (p_ < NMETA) { kp_ = KM + p_ * 512; vp_ = VM + p_ * 512; } else { int rr_ = p_ - NMETA; rr_ = rr_ > SEQ - 1 ? SEQ - 1 : rr_; kp_ = K + ((size_t)b * SEQ + rr_) * 512; vp_ = V + ((size_t)b * SEQ + rr_) * 512; } \
        kreg = *(const v4u*)(kp_ + 64 * h + 8 * sch); vreg = *(const v4u*)(vp_ + 64 * h + 8 * sch); \
        if (tid < 64) { int pf_ = 64 * (jt) + tid; pf_ = pf_ > LTOT - 1 ? LTOT - 1 : pf_; fkreg = CF[pf_] * LOG2E; } } while (0)
    AT_LOAD(0);
    for (int jt = 0; jt < ntiles; ++jt) {
        LAS unsigned char* buf = F.lds + (jt & 1) * AT_BUF;
        LAS bf16* Ks = (LAS bf16*)buf; LAS bf16* Vt = (LAS bf16*)(buf + 64 * AT_KP * 2); LAS float* Fk = (LAS float*)(buf + 64 * AT_KP * 2 + 64 * AT_VP * 2);
        *(LAS v4u*)(Ks + skey * AT_KP + 8 * sch) = kreg;
        { const unsigned vv[4] = {vreg.x, vreg.y, vreg.z, vreg.w};
#pragma unroll
          for (int e = 0; e < 4; ++e) { Vt[(8 * sch + 2 * e) * AT_VP + skey] = (bf16)(vv[e] & 0xffffu); Vt[(8 * sch + 2 * e + 1) * AT_VP + skey] = (bf16)(vv[e] >> 16); } }
        if (tid < 64) Fk[tid] = fkreg;
        __syncthreads();
        if (jt + 1 < ntiles) AT_LOAD(jt + 1);
        if (jt <= jmax) {
            f32x16 p0, p1;
#pragma unroll
            for (int r = 0; r < 16; ++r) { p0[r] = 0.f; p1[r] = 0.f; }
#pragma unroll
            for (int s = 0; s < 4; ++s) {
                const bf16x8 k0 = *(const LAS bf16x8*)(Ks + q * AT_KP + 16 * s + 8 * hi), k1 = *(const LAS bf16x8*)(Ks + (32 + q) * AT_KP + 16 * s + 8 * hi);
                p0 = __builtin_amdgcn_mfma_f32_32x32x16_bf16(k0, Qf[s], p0, 0, 0, 0); p1 = __builtin_amdgcn_mfma_f32_32x32x16_bf16(k1, Qf[s], p1, 0, 0, 0); }
            const bool need_mask = (64 * jt + 63) > (NMETA + t0w);
            float mx = -1e30f;
#pragma unroll
            for (int g4 = 0; g4 < 4; ++g4) { const f32x4 f0 = *(const LAS f32x4*)(Fk + 8 * g4 + 4 * hi), f1 = *(const LAS f32x4*)(Fk + 32 + 8 * g4 + 4 * hi);
#pragma unroll
                for (int e = 0; e < 4; ++e) { const int r = 4 * g4 + e;
                    float a = fmaf(p0[r], 0.125f * LOG2E, Fq - f0[e]), c = fmaf(p1[r], 0.125f * LOG2E, Fq - f1[e]);
                    if (need_mask) { const int pk = 64 * jt + 8 * g4 + 4 * hi + e; if (pk > pq) a = -1e30f; if (pk + 32 > pq) c = -1e30f; }
                    p0[r] = a; p1[r] = c; mx = fmaxf(mx, fmaxf(a, c)); } }
            mx = fmaxf(mx, __shfl_xor(mx, 32));
            const float mnew = fmaxf(mrun, mx), alpha = __builtin_amdgcn_exp2f(mrun - mnew); mrun = mnew;
            float ps = 0.f;
#pragma unroll
            for (int r = 0; r < 16; ++r) { p0[r] = __builtin_amdgcn_exp2f(p0[r] - mnew); p1[r] = __builtin_amdgcn_exp2f(p1[r] - mnew); ps += p0[r] + p1[r]; }
            lrun = lrun * alpha + ps;
#pragma unroll
            for (int r = 0; r < 16; ++r) { O0[r] *= alpha; O1[r] *= alpha; }
#pragma unroll
            for (int t = 0; t < 4; ++t) {
                v4u pw;
                if (t < 2) { const int o = 8 * (t & 1); pw.x = pk2(p0[o], p0[o + 1]); pw.y = pk2(p0[o + 2], p0[o + 3]); pw.z = pk2(p0[o + 4], p0[o + 5]); pw.w = pk2(p0[o + 6], p0[o + 7]); }
                else { const int o = 8 * (t & 1); pw.x = pk2(p1[o], p1[o + 1]); pw.y = pk2(p1[o + 2], p1[o + 3]); pw.z = pk2(p1[o + 4], p1[o + 5]); pw.w = pk2(p1[o + 6], p1[o + 7]); }
                const bf16x8 pb = __builtin_bit_cast(bf16x8, pw);
                const int key0 = 32 * (t >> 1) + 16 * (t & 1) + 4 * hi;
                const v2u a0 = *(const LAS v2u*)(Vt + q * AT_VP + key0), a1 = *(const LAS v2u*)(Vt + q * AT_VP + key0 + 8);
                const v2u b0 = *(const LAS v2u*)(Vt + (32 + q) * AT_VP + key0), b1 = *(const LAS v2u*)(Vt + (32 + q) * AT_VP + key0 + 8);
                const v4u va = {a0.x, a0.y, a1.x, a1.y}, vb = {b0.x, b0.y, b1.x, b1.y};
                O0 = __builtin_amdgcn_mfma_f32_32x32x16_bf16(__builtin_bit_cast(bf16x8, va), pb, O0, 0, 0, 0);
                O1 = __builtin_amdgcn_mfma_f32_32x32x16_bf16(__builtin_bit_cast(bf16x8, vb), pb, O1, 0, 0, 0);
            }
        }
    }
#undef AT_LOAD
    const float inv = 1.0f / (lrun + __shfl_xor(lrun, 32));
    bf16* op = ATT + rowq * 512 + 64 * h;
#pragma unroll
    for (int g4 = 0; g4 < 4; ++g4) { v2u w0, w1;
        w0.x = pk2(O0[4 * g4] * inv, O0[4 * g4 + 1] * inv); w0.y = pk2(O0[4 * g4 + 2] * inv, O0[4 * g4 + 3] * inv);
        w1.x = pk2(O1[4 * g4] * inv, O1[4 * g4 + 1] * inv); w1.y = pk2(O1[4 * g4 + 2] * inv, O1[4 * g4 + 3] * inv);
        *(v2u*)(op + 8 * g4 + 4 * hi) = w0; *(v2u*)(op + 32 + 8 * g4 + 4 * hi) = w1; }
    __syncthreads();
}

__device__ __forceinline__ void p6_fixup(Frame& F) {
    const float* EDGE = (const float*)(F.ws + WS_EDGE); const float* EM = (const float*)(F.ws + WS_EDGEM);
    const float* CP = (const float*)(F.ws + WS_CP); bf16* ACT = (bf16*)(F.ws + WS_ACT);
    const int total = 512 * 2 * (FF / 4);
    for (int i = blockIdx.x * 512 + F.tid; i < total; i += F.G * 512) {
        const int c4 = (i % (FF / 4)) * 4, rr = (i / (FF / 4)) & 1, rb = i / (2 * (FF / 4));
        const bool first = (rb & 31) == 0;
        float o[4];
#pragma unroll
        for (int e = 0; e < 4; ++e) { const int c = c4 + e;
            const float* e0 = EDGE + ((size_t)rb * FF + c) * 8; const float* ep = EDGE + ((size_t)(rb - 1) * FF + c) * 8;
            float v2, v1, v0, g2, g1, g0;
            if (rr == 0) { v0 = e0[0]; g0 = e0[4];
                if (first) { v2 = EM[c]; g2 = EM[FF + c]; v1 = EM[FF2 + c]; g1 = EM[FF2 + FF + c]; } else { v2 = ep[2]; g2 = ep[6]; v1 = ep[3]; g1 = ep[7]; } }
            else { v0 = e0[1]; g0 = e0[5]; v1 = e0[0]; g1 = e0[4];
                if (first) { v2 = EM[FF2 + c]; g2 = EM[FF2 + FF + c]; } else { v2 = ep[3]; g2 = ep[7]; } }
            const float* cp = CP + c * 8;
            const float ov = cp[3] + cp[0] * v2 + cp[1] * v1 + cp[2] * v0;
            const float og = cp[7] + cp[4] * g2 + cp[5] * g1 + cp[6] * g0;
            o[e] = og * fsigm(og) * ov; }
        v2u w; w.x = pk2(o[0], o[1]); w.y = pk2(o[2], o[3]);
        *(v2u*)(ACT + (size_t)(64 * rb + rr) * FF + c4) = w;
    }
}

__device__ __forceinline__ void p8_final(Frame& F) {
    const int gw = F.vcu * 8 + F.wave, NGW = F.G * 8, lane = F.lane;
    const float* rowss = (const float*)(F.ws + WS_ROWSS2);
    f32x4 gv[4];
#pragma unroll
    for (int j = 0; j < 4; ++j) gv[j] = ((const f32x4*)F.in[21])[lane + 64 * j];
    for (int m = gw; m < MROWS; m += NGW) { const float rstd = rsqrtf(rowss[m] * (1.f / DM) + RMS_EPS); f32x4* o = (f32x4*)(F.out + (size_t)m * DM) + lane;
#pragma unroll
        for (int j = 0; j < 4; ++j) o[64 * j] = o[64 * j] * rstd * gv[j]; }
}

#ifndef MK_SKIP
#define MK_SKIP 0
#endif
#ifndef MK_PROBE_ON
#define MK_PROBE_ON 0
#define MK_PROBE_A 0
#define MK_PROBE_B 9
#endif
__global__ void __launch_bounds__(512, 2) mk_fwd(Args args) {
    extern __shared__ __attribute__((aligned(16))) unsigned char lds_raw[];
    Frame F;
    F.lds = (LAS unsigned char*)lds_raw; F.ws = args.ws; F.in = args.in; F.out = args.out;
    F.tid = threadIdx.x; F.lane = F.tid & 63; F.wave = __builtin_amdgcn_readfirstlane(F.tid >> 6);
    F.G = gridDim.x; { const int bx = blockIdx.x; F.vcu = (F.G % 8 == 0) ? (bx % 8) * (F.G / 8) + bx / 8 : bx; }
    const int lo = args.ph_lo, hi = args.ph_hi;
#if MK_PROBE_ON
    unsigned long long ts_a = 0, ts_b = 0;
#define STAMP(k) do { if ((k) == MK_PROBE_A) ts_a = __builtin_amdgcn_s_memrealtime(); if ((k) == MK_PROBE_B) ts_b = __builtin_amdgcn_s_memrealtime(); } while (0)
#else
#define STAMP(k) do {} while (0)
#endif
#define IN(k) (lo <= (k) && (k) < hi)
#define SEAM(k) do { if (IN(k) && IN((k) + 1)) cg::this_grid().sync(); } while (0)
    unsigned char* ws = args.ws;
    bf16* QKVU = (bf16*)(ws + WS_QKVU); bf16* GATE = (bf16*)(ws + WS_GATE);

    STAMP(0);
#if !((MK_SKIP >> 0) & 1)
    if (IN(0)) { p0_prologue(F); __syncthreads(); }
#endif
    SEAM(0);

    STAMP(1);
#if !((MK_SKIP >> 1) & 1)
    if (IN(1)) {
        p1_extras(F);
        pg8::Gemm g{(const bf16*)(ws + WS_RA), (const bf16*)(ws + WS_WIN), MROWS, 4096, 1024}; pg8::StaticOrder S; S.init(MROWS, 4096, F.G, (int)blockIdx.x);
        pg8::EpiProj E{QKVU, GATE};
        pg8::gemm_phase<pg8::EpiProj, pg8::StaticOrder, true, true>(F.lds, g, S, E);
    }
#endif
    SEAM(1);

    STAMP(2);
#if !((MK_SKIP >> 2) & 1)
    if (IN(2)) {
        meta_p2(F);
        for (int u = F.vcu; u < 256; u += F.G) s5_unit(F, u & 31, u >> 5);
        for (int pu = F.vcu; pu < 512; pu += F.G) { const int bh = pu >> 2, qp = pu & 3; attn_unit(F, bh >> 3, bh & 7, 7 - qp); attn_unit(F, bh >> 3, bh & 7, qp); }
    }
#endif
    SEAM(2);

    STAMP(3);
#if !((MK_SKIP >> 3) & 1)
    if (IN(3)) {
        meta_p3(F);
        { pg8::Gemm g{(const bf16*)(ws + WS_RB), (const bf16*)(ws + WS_WA), MROWS, 1024, 512}; pg8::PairOrder S{F.G, F.vcu, 2};
          pg8::EpiYa E{GATE, F.out};
          pg8::gemm_phase<pg8::EpiYa, pg8::PairOrder, true, true>(F.lds, g, S, E); }
        { pg8::Gemm g{(const bf16*)(ws + WS_RB + 32 * MiB), (const bf16*)(ws + WS_WG), MROWS, 2048, 512}; pg8::PairOrder S{F.G, F.vcu, 4};
          pg8::EpiGlu E{GATE, F.out, (bf16*)(ws + WS_RA)};
          pg8::gemm_phase<pg8::EpiGlu, pg8::PairOrder, true, true>(F.lds, g, S, E); }
    }
#endif
    SEAM(3);

    STAMP(4);
#if !((MK_SKIP >> 4) & 1)
    if (IN(4)) {
        meta_p4(F);
        pg8::Gemm g{(const bf16*)(ws + WS_RA), (const bf16*)(ws + WS_WO), MROWS, 1024, 1024}; pg8::StaticOrder S; S.init(MROWS, 1024, F.G, (int)blockIdx.x);
        pg8::EpiRes<true> E{F.in[0], F.out, (bf16*)(ws + WS_RB), (float*)(ws + WS_ROWSS1)};
        pg8::gemm_phase<pg8::EpiRes<true>, pg8::StaticOrder, true, true>(F.lds, g, S, E);
    }
#endif
    SEAM(4);

    STAMP(5);
#if !((MK_SKIP >> 5) & 1)
    if (IN(5)) {
        meta_p5(F);
        pg8::Gemm g{(const bf16*)(ws + WS_RB), (const bf16*)(ws + WS_WUP), MROWS, FF2, 1024}; pg8::StaticOrder S; S.init(MROWS, FF2, F.G, (int)blockIdx.x);
        pg8::EpiUp E{(const float*)(ws + WS_ROWSS1), (const float*)(ws + WS_CP), (bf16*)(ws + WS_ACT), (float*)(ws + WS_EDGE)};
        pg8::gemm_phase<pg8::EpiUp, pg8::StaticOrder, true, true>(F.lds, g, S, E);
    }
#endif
    SEAM(5);

    STAMP(6);
#if !((MK_SKIP >> 6) & 1)
    if (IN(6)) { p6_fixup(F); }
#endif
    SEAM(6);

    STAMP(7);
#if !((MK_SKIP >> 7) & 1)
    if (IN(7)) {
        pg8::Gemm g{(const bf16*)(ws + WS_ACT), (const bf16*)(ws + WS_WDN), MROWS, 1024, FF}; pg8::StaticOrder S; S.init(MROWS, 1024, F.G, (int)blockIdx.x);
        pg8::EpiRes<false> E{F.out, F.out, nullptr, (float*)(ws + WS_ROWSS2)};
        pg8::gemm_phase<pg8::EpiRes<false>, pg8::StaticOrder, true, true>(F.lds, g, S, E);
    }
#endif
    SEAM(7);

    STAMP(8);
#if !((MK_SKIP >> 8) & 1)
    if (IN(8)) { p8_final(F); }
#endif
    STAMP(9);
#if MK_PROBE_ON
    __syncthreads();
    if (blockIdx.x == 0 && F.tid == 0) F.out[0] += (float)(ts_b - ts_a) * 0.01f;
#endif
#undef IN
#undef SEAM
}

extern "C" void kernel_launch(void* const* d_in, const int* in_sizes, int n_in, void* d_out, int out_size, void* d_ws, size_t ws_size, hipStream_t stream) {
    static int grid = 0;
    if (grid == 0) {
        if (n_in != 22 || in_sizes[0] != MROWS * DM || out_size != MROWS * DM || ws_size < WS_END) { fprintf(stderr, "kernel_launch: unexpected shapes / workspace (n_in %d, ws %zu)\n", n_in, ws_size); grid = -1; return; }
        int dev = 0, cus = 0, per_cu = 0;
        if (hipGetDevice(&dev) != hipSuccess || hipDeviceGetAttribute(&cus, hipDeviceAttributeMultiprocessorCount, dev) != hipSuccess) { grid = -1; return; }
        if (hipFuncSetAttribute((const void*)mk_fwd, hipFuncAttributeMaxDynamicSharedMemorySize, LDS_BYTES) != hipSuccess) { fprintf(stderr, "kernel_launch: hipFuncSetAttribute failed\n"); grid = -1; return; }
        if (hipOccupancyMaxActiveBlocksPerMultiprocessor(&per_cu, (const void*)mk_fwd, 512, LDS_BYTES) != hipSuccess || per_cu < 1) { fprintf(stderr, "kernel_launch: occupancy query failed (%d)\n", per_cu); (void)hipGetLastError(); per_cu = 1; }
        grid = cus * per_cu;
        if (grid > 256) grid = 256;
    }
    if (grid < 0) return;
    Args a{};
    for (int i = 0; i < 22; ++i) a.in[i] = (const float*)d_in[i];
    a.out = (float*)d_out; a.ws = (unsigned char*)d_ws;
#if MK_PER_PHASE
    for (int p = 0; p < NPHASE; ++p) { a.ph_lo = p; a.ph_hi = p + 1; hipLaunchKernelGGL(mk_fwd, dim3(grid), dim3(512), LDS_BYTES, stream, a); }
#else
    a.ph_lo = 0; a.ph_hi = NPHASE;
    void* kargs[] = {&a};
    hipError_t e = hipLaunchCooperativeKernel((const void*)mk_fwd, dim3(grid), dim3(512), kargs, LDS_BYTES, stream);
    if (e != hipSuccess) fprintf(stderr, "cooperative launch failed: %s (grid %d)\n", hipGetErrorString(e), grid);
#endif
}
```

```cpp
#include <hip/hip_runtime.h>
#include <hip/hip_cooperative_groups.h>
#include <cstdio>
#include <cstdint>
namespace cg = cooperative_groups;

#ifndef MK_PER_PHASE
#define MK_PER_PHASE 0
#endif

constexpr int NB = 16, SEQ = 2048, NMETA = 16, DM = 1024, MROWS = NB * SEQ;
constexpr int NH = 8, DH = 64, AW = 512, SW = 512, NG = 32, NP = 64, FF = 2816, FF2 = 5632, INW = 4104;
constexpr int LTOT = SEQ + NMETA;
constexpr float RMS_EPS = 1e-6f;
constexpr float LOG2E = 1.4426950408889634f;
constexpr int NPHASE = 9;
namespace pg8 {
#define PG8_LAS __attribute__((address_space(3)))
typedef unsigned short bf16_t;
typedef short bf16x8 __attribute__((ext_vector_type(8)));
typedef float f32x4 __attribute__((ext_vector_type(4)));
typedef unsigned u32x4 __attribute__((ext_vector_type(4)));
constexpr int BM = 256, BK = 64, HALF = 128, HTB = HALF * BK * 2  , STAGE_BYTES = 8 * HTB, NXCD = 8, WGM = 8;

__host__ __device__ __forceinline__ int lds_byte(int r, int c) { const int st = (r >> 4) * 2 + (c >> 5), rr = r & 15, cc = c & 31, ob = rr * 64 + cc * 2; return st * 1024 + (ob ^ (((ob >> 9) & 1) << 5)); }
__host__ __device__ __forceinline__ void stage_rc(int b, int& R, int& C) { const int st = b / 1024, sb = b % 1024, swz = sb ^ (((sb >> 9) & 1) << 5); R = (st >> 1) * 16 + swz / 64; C = (st & 1) * 32 + (swz % 64) / 2; }
__host__ __device__ __forceinline__ int perm32(int rho) { const int n = rho >> 4, i = rho & 15; return 8 * (i >> 2) + 4 * n + (i & 3); }

struct Unit { int pm, pn; };
struct Gemm { const bf16_t* A; const bf16_t* Bt; int M, N, K; };

struct StaticOrder {
    int nM, nN, nwg, G, c;
    __host__ __device__ void init(int M, int N, int G_, int c_) { nM = M / BM; nN = N / BM; nwg = nM * nN; G = G_; c = c_; }
    __host__ __device__ bool next(int i, Unit& u) const {
        const long L = (long)i * G + c; if (L >= nwg) return false;
        int wgid = (int)L; { const int q = nwg / NXCD, r = nwg % NXCD, xcd = wgid % NXCD, off = wgid / NXCD; wgid = (xcd < r ? xcd * (q + 1) : r * (q + 1) + (xcd - r) * q) + off; }
        const int nig = WGM * nN, gid = wgid / nig, fm = gid * WGM, gsz = (nM - fm) < WGM ? (nM - fm) : WGM;
        u.pm = fm + ((wgid % nig) % gsz); u.pn = (wgid % nig) / gsz; return true;
    }
    __device__ __forceinline__ void a_ready(const Unit&) const {}
    __device__ __forceinline__ void done(const Unit&) const {}
};

__device__ __forceinline__ unsigned cvt_pk_bf16(float lo, float hi) { unsigned r; asm volatile("v_cvt_pk_bf16_f32 %0, %1, %2" : "=v"(r) : "v"(lo), "v"(hi)); return r; }
typedef float f32x2 __attribute__((ext_vector_type(2)));
typedef unsigned u32x4e __attribute__((ext_vector_type(4)));
typedef unsigned u32x2e __attribute__((ext_vector_type(2)));
__device__ __forceinline__ float fsig(float x) { return __builtin_amdgcn_rcpf(1.0f + __builtin_amdgcn_exp2f(-1.4426950408889634f * x)); }
__device__ __forceinline__ float bf_lo(unsigned w) { return __uint_as_float(w << 16); }
__device__ __forceinline__ float bf_hi(unsigned w) { return __uint_as_float(w & 0xffff0000u); }

struct EpiProj {
    static constexpr bool PERM = true, AFTER_DRAIN = false;
    bf16_t* QKVU; bf16_t* GATE;
    __device__ __forceinline__ void operator()(const f32x4 (&acc)[2][2][4][2], const Unit& u, int wr, int wc, int fr, int fq) const {
        const int row0 = u.pm * BM + wr * 64 + fr;
        const bool isg = u.pn >= 8;
        bf16_t* base; int ldc, colt;
        if (!isg) { base = QKVU + (size_t)(u.pn >> 1) * ((size_t)32768 * 512); ldc = 512; colt = (u.pn & 1) * 256; }
        else { base = GATE; ldc = 2048; colt = (u.pn - 8) * 256; }
        const int col0 = colt + wc * 32 + 8 * fq;
#pragma unroll
        for (int ai = 0; ai < 2; ++ai)
#pragma unroll
            for (int m = 0; m < 4; ++m) { bf16_t* rowp = base + (size_t)(row0 + ai * HALF + m * 16) * ldc + col0;
#pragma unroll
                for (int bj = 0; bj < 2; ++bj) { f32x4 v0 = acc[ai][bj][m][0], v1 = acc[ai][bj][m][1];
                    if (isg) { v0 = (f32x4){fsig(v0[0]), fsig(v0[1]), fsig(v0[2]), fsig(v0[3])}; v1 = (f32x4){fsig(v1[0]), fsig(v1[1]), fsig(v1[2]), fsig(v1[3])}; }
                    u32x4e w; w.x = cvt_pk_bf16(v0[0], v0[1]); w.y = cvt_pk_bf16(v0[2], v0[3]); w.z = cvt_pk_bf16(v1[0], v1[1]); w.w = cvt_pk_bf16(v1[2], v1[3]);
                    *(u32x4e*)(rowp + bj * HALF) = w; } }
    }
};

struct EpiYa {
    static constexpr bool PERM = true, AFTER_DRAIN = false;
    const bf16_t* GATE; float* PART;
    __device__ __forceinline__ void operator()(const f32x4 (&acc)[2][2][4][2], const Unit& u, int wr, int wc, int fr, int fq) const {
        const int row0 = u.pm * BM + wr * 64 + fr, col0 = u.pn * BM + wc * 32 + 8 * fq;
#pragma unroll
        for (int ai = 0; ai < 2; ++ai)
#pragma unroll
            for (int m = 0; m < 4; ++m) { const size_t row = (size_t)(row0 + ai * HALF + m * 16);
#pragma unroll
                for (int bj = 0; bj < 2; ++bj) { const int col = col0 + bj * HALF;
                    const u32x4e g = *(const u32x4e*)(GATE + row * 2048 + col);
                    f32x4 v0 = acc[ai][bj][m][0], v1 = acc[ai][bj][m][1];
                    v0 = v0 * (f32x4){bf_lo(g.x), bf_hi(g.x), bf_lo(g.y), bf_hi(g.y)}; v1 = v1 * (f32x4){bf_lo(g.z), bf_hi(g.z), bf_lo(g.w), bf_hi(g.w)};
                    float* p = PART + row * 1024 + col; *(f32x4*)p = v0; *(f32x4*)(p + 4) = v1; } }
    }
};

struct EpiGlu {
    static constexpr bool PERM = true, AFTER_DRAIN = false;
    const bf16_t* GATE; const float* PART; bf16_t* MERGED;
    __device__ __forceinline__ void operator()(const f32x4 (&acc)[2][2][4][2], const Unit& u, int wr, int wc, int fr, int fq) const {
        const int row0 = u.pm * BM + wr * 64 + fr, col = u.pn * HALF + wc * 32 + 8 * fq;
#pragma unroll
        for (int ai = 0; ai < 2; ++ai)
#pragma unroll
            for (int m = 0; m < 4; ++m) { const size_t row = (size_t)(row0 + ai * HALF + m * 16);
                const u32x4e g = *(const u32x4e*)(GATE + row * 2048 + 1024 + col);
                const float* p = PART + row * 1024 + col; const f32x4 p0 = *(const f32x4*)p, p1 = *(const f32x4*)(p + 4);
                const f32x4 a0 = acc[ai][0][m][0], a1 = acc[ai][0][m][1], b0 = acc[ai][1][m][0], b1 = acc[ai][1][m][1];
                f32x4 y0 = (f32x4){a0[0] * fsig(b0[0]), a0[1] * fsig(b0[1]), a0[2] * fsig(b0[2]), a0[3] * fsig(b0[3])};
                f32x4 y1 = (f32x4){a1[0] * fsig(b1[0]), a1[1] * fsig(b1[1]), a1[2] * fsig(b1[2]), a1[3] * fsig(b1[3])};
                y0 = p0 + y0 * (f32x4){bf_lo(g.x), bf_hi(g.x), bf_lo(g.y), bf_hi(g.y)}; y1 = p1 + y1 * (f32x4){bf_lo(g.z), bf_hi(g.z), bf_lo(g.w), bf_hi(g.w)};
                u32x4e w; w.x = cvt_pk_bf16(y0[0], y0[1]); w.y = cvt_pk_bf16(y0[2], y0[3]); w.z = cvt_pk_bf16(y1[0], y1[1]); w.w = cvt_pk_bf16(y1[2], y1[3]);
                *(u32x4e*)(MERGED + row * 1024 + col) = w; }
    }
};

template <bool WITH_BF> struct EpiRes {
    static constexpr bool PERM = true, AFTER_DRAIN = false;
    const float* base; float* out; bf16_t* OB; float* rowss;
    __device__ __forceinline__ void operator()(const f32x4 (&acc)[2][2][4][2], const Unit& u, int wr, int wc, int fr, int fq) const {
        const int row0 = u.pm * BM + wr * 64 + fr, col0 = u.pn * BM + wc * 32 + 8 * fq;
#pragma unroll
        for (int ai = 0; ai < 2; ++ai)
#pragma unroll
            for (int m = 0; m < 4; ++m) { const size_t row = (size_t)(row0 + ai * HALF + m * 16); float ss = 0.f;
#pragma unroll
                for (int bj = 0; bj < 2; ++bj) { const size_t off = row * 1024 + col0 + bj * HALF;
                    const f32x4 r0 = *(const f32x4*)(base + off), r1 = *(const f32x4*)(base + off + 4);
                    const f32x4 v0 = acc[ai][bj][m][0] + r0, v1 = acc[ai][bj][m][1] + r1;
                    *(f32x4*)(out + off) = v0; *(f32x4*)(out + off + 4) = v1;
                    ss += (v0[0] * v0[0] + v0[1] * v0[1]) + (v0[2] * v0[2] + v0[3] * v0[3]) + (v1[0] * v1[0] + v1[1] * v1[1]) + (v1[2] * v1[2] + v1[3] * v1[3]);
                    if (WITH_BF) { u32x4e w; w.x = cvt_pk_bf16(v0[0], v0[1]); w.y = cvt_pk_bf16(v0[2], v0[3]); w.z = cvt_pk_bf16(v1[0], v1[1]); w.w = cvt_pk_bf16(v1[2], v1[3]);
                        *(u32x4e*)(OB + off) = w; } }
                ss += __shfl_xor(ss, 16); ss += __shfl_xor(ss, 32);
                if (fq == 0) atomicAdd(rowss + row, ss); }
    }
};

struct EpiUp {
    static constexpr bool PERM = true, AFTER_DRAIN = false;
    const float* rowss; const float* CP; bf16_t* ACT; float* EDGE;
    __device__ __forceinline__ void operator()(const f32x4 (&acc)[2][2][4][2], const Unit& u, int wr, int wc, int fr, int fq) const {
        const int lane = fq * 16 + fr;
        const int ch0 = u.pn * HALF + wc * 32 + 8 * fq;
        const int idx1 = ((lane & ~15) | ((fr - 1) & 15)) << 2, idx2 = ((lane & ~15) | ((fr - 2) & 15)) << 2;
        const bool s15 = fr == 15, s14 = fr >= 14;
        const bool edge = fr < 2 || fr >= 14; const int slot = fr < 2 ? fr : fr - 12;
        const unsigned cpo = (unsigned)ch0 * 32u;
#pragma unroll
        for (int ai = 0; ai < 2; ++ai) {
            const int rowb = u.pm * BM + ai * HALF + wr * 64;
            const unsigned rso = (unsigned)(rowb + fr) * 4u;
            float rs[4];
#pragma unroll
            for (int m = 0; m < 4; ++m) rs[m] = rsqrtf(*(const float*)((const char*)rowss + rso + m * 64) * (1.0f / 1024.0f) + 1e-6f);
            const unsigned ebo = ((unsigned)(rowb >> 6) * 2816u + (unsigned)ch0) * 32u + (unsigned)slot * 4u;
            const unsigned aco = ((unsigned)(rowb + fr) * 2816u + (unsigned)ch0) * 2u;
#pragma unroll
            for (int n = 0; n < 2; ++n) {
                float ov[4][4];
#pragma unroll
                for (int e = 0; e < 4; ++e) {
                    const f32x4 wv = *(const f32x4*)((const char*)CP + cpo + (4 * n + e) * 32), wg = *(const f32x4*)((const char*)CP + cpo + (4 * n + e) * 32 + 16);
                    float hv[4], hg[4];
#pragma unroll
                    for (int m = 0; m < 4; ++m) { hv[m] = acc[ai][0][m][n][e] * rs[m]; hg[m] = acc[ai][1][m][n][e] * rs[m]; }
                    if (edge) { const float ev = fr < 2 ? hv[0] : hv[3], eg = fr < 2 ? hg[0] : hg[3];
                        *(float*)((char*)EDGE + ebo + (4 * n + e) * 32) = ev; *(float*)((char*)EDGE + ebo + (4 * n + e) * 32 + 16) = eg; }
#pragma unroll
                    for (int m = 0; m < 4; ++m) {
                        const float pv = m > 0 ? hv[m - 1] : 0.f, pg = m > 0 ? hg[m - 1] : 0.f;
                        const float v1 = __int_as_float(__builtin_amdgcn_ds_bpermute(idx1, __float_as_int(s15 ? pv : hv[m])));
                        const float v2 = __int_as_float(__builtin_amdgcn_ds_bpermute(idx2, __float_as_int(s14 ? pv : hv[m])));
                        const float g1 = __int_as_float(__builtin_amdgcn_ds_bpermute(idx1, __float_as_int(s15 ? pg : hg[m])));
                        const float g2 = __int_as_float(__builtin_amdgcn_ds_bpermute(idx2, __float_as_int(s14 ? pg : hg[m])));
                        const float o1 = wv[3] + wv[0] * v2 + wv[1] * v1 + wv[2] * hv[m];
                        const float og = wg[3] + wg[0] * g2 + wg[1] * g1 + wg[2] * hg[m];
                        ov[m][e] = og * fsig(og) * o1;
                    }
                }
#pragma unroll
                for (int m = 0; m < 4; ++m) { u32x2e w; w.x = cvt_pk_bf16(ov[m][0], ov[m][1]); w.y = cvt_pk_bf16(ov[m][2], ov[m][3]);
                    *(u32x2e*)((char*)ACT + aco + (unsigned)(m * 16 * 2816 * 2) + n * 8) = w; }
                asm volatile("" ::: "memory");
            }
        }
    }
};

struct PairOrder {
    int G, c, per;
    __device__ bool next(int i, Unit& u) const { const int su = (i / per) * G + c; if (su >= 256) return false; u.pm = su >> 1; u.pn = (su & 1) * per + (i % per); return true; }
    __device__ __forceinline__ void a_ready(const Unit&) const {}
    __device__ __forceinline__ void done(const Unit&) const {}
};

template <class Epi, class Sched, bool ALIGN_EPI = false, bool SP2 = false>
__device__ __forceinline__ void gemm_phase(PG8_LAS unsigned char* lds, const Gemm g, const Sched& S, const Epi& E) {
    const int tid = threadIdx.x, wid = __builtin_amdgcn_readfirstlane(tid >> 6), lane = tid & 63, wr = wid >> 2, wc = wid & 3, fr = lane & 15, fq = lane >> 4;
    const int K = g.K, nt = K / BK;
    unsigned voffA[2], voffB[2];
#pragma unroll
    for (int i = 0; i < 2; ++i) { int R, C; stage_rc(tid * 16 + i * 8192, R, C); const int Rb = Epi::PERM ? ((R & ~31) + perm32(R & 31)) : R;
        voffA[i] = (unsigned)(R * K + C) * 2u; voffB[i] = (unsigned)(Rb * K + C) * 2u; }
    const size_t kstep = (size_t)(BK * 2);
    const size_t hstep = (size_t)HALF * K * 2;
    const size_t tstep = 2 * hstep;
    const unsigned ldsw = (unsigned)wid * 1024u;
    const int aoff = lds_byte(wr * 64 + fr, fq * 8), boff = lds_byte(wc * 32 + fr, fq * 8);
#define PG8_SA(b, h) (((b) * 2 + (h)) * HTB)
#define PG8_SB(b, h) ((4 + (b) * 2 + (h)) * HTB)
#define PG8_STAGE(bufoff, gbase, voff) do { _Pragma("unroll") for (int _i = 0; _i < 2; ++_i) \
        __builtin_amdgcn_global_load_lds((const unsigned*)((const char*)(gbase) + (voff)[_i]), (PG8_LAS unsigned*)(lds + (bufoff) + ldsw + _i * 8192), 16, 0, 0); } while (0)
#define PG8_LDA(dst, b, h) do { _Pragma("unroll") for (int m = 0; m < 4; ++m) _Pragma("unroll") for (int k = 0; k < 2; ++k) dst[m][k] = *(const PG8_LAS bf16x8*)(lds + PG8_SA(b, h) + aoff + m * 2048 + k * 1024); } while (0)
#define PG8_LDB(dst, b, h) do { _Pragma("unroll") for (int n = 0; n < 2; ++n) _Pragma("unroll") for (int k = 0; k < 2; ++k) dst[n][k] = *(const PG8_LAS bf16x8*)(lds + PG8_SB(b, h) + boff + n * 2048 + k * 1024); } while (0)
#define PG8_MMA(ai, bj, At, Bt) do { __builtin_amdgcn_s_setprio(1); _Pragma("unroll") for (int m = 0; m < 4; ++m) _Pragma("unroll") for (int n = 0; n < 2; ++n) _Pragma("unroll") for (int k = 0; k < 2; ++k) \
        acc[ai][bj][m][n] = __builtin_amdgcn_mfma_f32_16x16x32_bf16(Bt[n][k], At[m][k], acc[ai][bj][m][n], 0, 0, 0); __builtin_amdgcn_s_setprio(0); } while (0)
#define PG8_WAIT_V(n) asm volatile("s_waitcnt vmcnt(" #n ")" ::: "memory")
#define PG8_WAIT_L(n) asm volatile("s_waitcnt lgkmcnt(" #n ")" ::: "memory")
#define PG8_BAR __builtin_amdgcn_s_barrier()
#define PG8_SCHED __builtin_amdgcn_sched_barrier(0)
    Unit cur, nxt; int ui = 0;
    if (!S.next(0, cur)) return;
    f32x4 acc[2][2][4][2];
#pragma unroll
    for (int a = 0; a < 2; ++a)
#pragma unroll
        for (int b = 0; b < 2; ++b)
#pragma unroll
            for (int m = 0; m < 4; ++m)
#pragma unroll
                for (int n = 0; n < 2; ++n) acc[a][b][m][n] = (f32x4){0.f, 0.f, 0.f, 0.f};
    bf16x8 At[4][2], B0[2][2], B1[2][2];
    const char* cA = (const char*)g.A + (size_t)cur.pm * tstep; const char* cB = (const char*)g.Bt + (size_t)cur.pn * tstep;
    S.a_ready(cur);
    if constexpr (SP2) {
        PG8_STAGE(PG8_SB(0, 0), cB, voffB); PG8_STAGE(PG8_SB(0, 1), cB + hstep, voffB); PG8_STAGE(PG8_SA(0, 0), cA, voffA); PG8_STAGE(PG8_SA(0, 1), cA + hstep, voffA);
        if (wr == 1) PG8_BAR;
        PG8_WAIT_V(2); PG8_BAR;
        PG8_STAGE(PG8_SB(1, 0), cB + kstep, voffB); PG8_STAGE(PG8_SA(1, 0), cA + kstep, voffA); PG8_STAGE(PG8_SB(1, 1), cB + hstep + kstep, voffB);
        PG8_WAIT_V(6); PG8_BAR;
    } else {
        PG8_STAGE(PG8_SB(0, 0), cB, voffB); PG8_STAGE(PG8_SA(0, 0), cA, voffA); PG8_STAGE(PG8_SB(0, 1), cB + hstep, voffB); PG8_STAGE(PG8_SA(0, 1), cA + hstep, voffA);
        if (wr == 1) PG8_BAR;
        PG8_WAIT_V(4); PG8_BAR;
        PG8_STAGE(PG8_SB(1, 0), cB + kstep, voffB); PG8_STAGE(PG8_SA(1, 0), cA + kstep, voffA); PG8_STAGE(PG8_SB(1, 1), cB + hstep + kstep, voffB);
        PG8_WAIT_V(6); PG8_BAR;
    }
    for (;;) {
        const bool has_next = S.next(ui + 1, nxt);
        const char* nA = has_next ? (const char*)g.A + (size_t)nxt.pm * tstep : cA; const char* nB = has_next ? (const char*)g.Bt + (size_t)nxt.pn * tstep : cB;
        for (int t = 0; t < nt; t += 2) {
            const bool last = (t == nt - 2);
            const char* a1 = cA + (size_t)(t + 1) * kstep;
            const char* a2 = last ? nA : cA + (size_t)(t + 2) * kstep; const char* b2 = last ? nB : cB + (size_t)(t + 2) * kstep;
            const char* a3 = a2 + kstep; const char* b3 = b2 + kstep;
            if (last && has_next) S.a_ready(nxt);
            if constexpr (SP2) {
            PG8_LDB(B0, 0, 0); PG8_LDB(B1, 0, 1); PG8_SCHED; PG8_LDA(At, 0, 0); PG8_STAGE(PG8_SA(1, 1), a1 + hstep, voffA);
            PG8_WAIT_V(8); PG8_WAIT_L(0); PG8_BAR; PG8_MMA(0, 0, At, B0); PG8_MMA(0, 1, At, B1); PG8_BAR; PG8_SCHED;
            PG8_LDA(At, 0, 1); PG8_STAGE(PG8_SB(0, 0), b2, voffB); PG8_STAGE(PG8_SB(0, 1), b2 + hstep, voffB); PG8_STAGE(PG8_SA(0, 0), a2, voffA);
            PG8_WAIT_V(8); PG8_WAIT_L(0); PG8_BAR; PG8_MMA(1, 0, At, B0); PG8_MMA(1, 1, At, B1); PG8_BAR; PG8_SCHED;
            PG8_LDB(B0, 1, 0); PG8_LDB(B1, 1, 1); PG8_SCHED; PG8_LDA(At, 1, 0); PG8_STAGE(PG8_SA(0, 1), a2 + hstep, voffA);
            PG8_WAIT_V(8); PG8_WAIT_L(0); PG8_BAR; PG8_MMA(0, 0, At, B0); PG8_MMA(0, 1, At, B1); PG8_BAR; PG8_SCHED;
            PG8_LDA(At, 1, 1); PG8_STAGE(PG8_SB(1, 0), b3, voffB); PG8_STAGE(PG8_SB(1, 1), b3 + hstep, voffB); PG8_STAGE(PG8_SA(1, 0), a3, voffA);
            PG8_WAIT_V(8); PG8_WAIT_L(0); PG8_BAR; PG8_MMA(1, 0, At, B0); PG8_MMA(1, 1, At, B1); PG8_BAR; PG8_SCHED;
            } else {
            PG8_LDB(B0, 0, 0); PG8_SCHED; PG8_LDA(At, 0, 0); PG8_STAGE(PG8_SA(1, 1), a1 + hstep, voffA);
            PG8_WAIT_L(8); PG8_BAR; PG8_WAIT_L(0); PG8_MMA(0, 0, At, B0); PG8_BAR; PG8_SCHED;
            PG8_LDB(B1, 0, 1); PG8_STAGE(PG8_SB(0, 0), b2, voffB);
            PG8_BAR; PG8_WAIT_L(0); PG8_MMA(0, 1, At, B1); PG8_BAR;
            PG8_LDA(At, 0, 1); PG8_STAGE(PG8_SA(0, 0), a2, voffA);
            PG8_BAR; PG8_WAIT_L(0); PG8_MMA(1, 0, At, B0); PG8_BAR; PG8_SCHED;
            PG8_STAGE(PG8_SB(0, 1), b2 + hstep, voffB);
            PG8_WAIT_V(6); PG8_BAR; PG8_MMA(1, 1, At, B1); PG8_BAR;
            PG8_LDB(B0, 1, 0); PG8_SCHED; PG8_LDA(At, 1, 0); PG8_STAGE(PG8_SA(0, 1), a2 + hstep, voffA);
            PG8_WAIT_L(8); PG8_BAR; PG8_WAIT_L(0); PG8_MMA(0, 0, At, B0); PG8_BAR; PG8_SCHED;
            PG8_LDB(B1, 1, 1); PG8_STAGE(PG8_SB(1, 0), b3, voffB);
            PG8_BAR; PG8_WAIT_L(0); PG8_MMA(0, 1, At, B1); PG8_BAR;
            PG8_LDA(At, 1, 1); PG8_STAGE(PG8_SA(1, 0), a3, voffA);
            PG8_BAR; PG8_WAIT_L(0); PG8_MMA(1, 0, At, B0); PG8_BAR; PG8_SCHED;
            PG8_STAGE(PG8_SB(1, 1), b3 + hstep, voffB);
            PG8_WAIT_V(6); PG8_BAR; PG8_MMA(1, 1, At, B1); PG8_BAR;
            }
        }
        if constexpr (ALIGN_EPI) { if (wr == 0) PG8_BAR; }
        if constexpr (!Epi::AFTER_DRAIN) { E(acc, cur, wr, wc, fr, fq); S.done(cur); }
        if (!has_next) break;
#pragma unroll
        for (int a = 0; a < 2; ++a)
#pragma unroll
            for (int b = 0; b < 2; ++b)
#pragma unroll
                for (int m = 0; m < 4; ++m)
#pragma unroll
                    for (int n = 0; n < 2; ++n) acc[a][b][m][n] = (f32x4){0.f, 0.f, 0.f, 0.f};
        cur = nxt; cA = nA; cB = nB; ++ui;
        if constexpr (ALIGN_EPI) { if (wr == 1) PG8_BAR; }
    }
    PG8_WAIT_V(0);
    if constexpr (!ALIGN_EPI) { if (wr == 0) PG8_BAR; }
    PG8_BAR;
    if constexpr (Epi::AFTER_DRAIN) { E.fused(acc, cur, wr, wc, fr, fq, lds, wid, lane); S.done(cur); }
#undef PG8_SA
#undef PG8_SB
#undef PG8_STAGE
#undef PG8_LDA
#undef PG8_LDB
#undef PG8_MMA
#undef PG8_WAIT_V
#undef PG8_WAIT_L
#undef PG8_BAR
#undef PG8_SCHED
}
}

#define LAS __attribute__((address_space(3)))
typedef unsigned short bf16;
typedef short bf16x8 __attribute__((ext_vector_type(8)));
typedef float f32x4 __attribute__((ext_vector_type(4)));
typedef float f32x16 __attribute__((ext_vector_type(16)));
typedef unsigned v4u __attribute__((ext_vector_type(4)));
typedef unsigned v2u __attribute__((ext_vector_type(2)));
typedef float f32x2v __attribute__((ext_vector_type(2)));
typedef __bf16 bf16x2n __attribute__((ext_vector_type(2)));
#define LDS_WAIT() asm volatile("s_waitcnt lgkmcnt(0)" ::: "memory")
__device__ __forceinline__ unsigned pk2(float lo, float hi) { f32x2v v = {lo, hi}; return __builtin_bit_cast(unsigned, __builtin_convertvector(v, bf16x2n)); }
__device__ __forceinline__ float bf2f(bf16 h) { return __uint_as_float((unsigned)h << 16); }
__device__ __forceinline__ float blo(unsigned w) { return __uint_as_float(w << 16); }
__device__ __forceinline__ float bhi(unsigned w) { return __uint_as_float(w & 0xffff0000u); }
__device__ __forceinline__ float fsigm(float x) { return __builtin_amdgcn_rcpf(1.0f + __builtin_amdgcn_exp2f(-LOG2E * x)); }
__device__ __forceinline__ float wave_sum(float v) {
#pragma unroll
    for (int o = 1; o < 64; o <<= 1) v += __shfl_xor(v, o);
    return v;
}

constexpr size_t MiB = 1u << 20;
constexpr size_t WS_ROWSS1 = 0, WS_ROWSS2 = 128 * 1024;
constexpr size_t WS_LOGFM = 256 * 1024;
constexpr size_t WS_BAR = 512 * 1024;
constexpr size_t WS_XNM = 1 * MiB;
constexpr size_t WS_QKVUM = WS_XNM + 64 * 1024;
constexpr size_t WS_GATEM = WS_QKVUM + 64 * 1024;
constexpr size_t WS_AA = WS_GATEM + 64 * 1024, WS_ZA = WS_AA + 16 * 1024;
constexpr size_t WS_MA = WS_ZA + 16 * 1024, WS_HA = WS_MA + 32 * 1024;
constexpr size_t WS_EDGEM = WS_HA + 32 * 1024;
constexpr size_t WS_CP = WS_EDGEM + 64 * 1024;
constexpr size_t WS_LOGF = 2 * MiB;
constexpr size_t WS_CUMF = 3 * MiB;
constexpr size_t WS_WIN = 6 * MiB, WS_WA = 14 * MiB, WS_WG = 15 * MiB, WS_WO = 17 * MiB, WS_WUP = 19 * MiB, WS_WDN = 30 * MiB;
constexpr size_t WS_RA = 36 * MiB;
constexpr size_t WS_RB = 100 * MiB;
constexpr size_t WS_QKVU = 164 * MiB;
constexpr size_t WS_GATE = 292 * MiB;
constexpr size_t WS_ACT = 164 * MiB;
constexpr size_t WS_EDGE = 420 * MiB;
constexpr size_t WS_END = 464 * MiB;
constexpr int LDS_BYTES = 135168;

struct Args { const float* in[22]; float* out; unsigned char* ws; int ph_lo, ph_hi; };

struct Frame {
    LAS unsigned char* lds; unsigned char* ws; const float* const* in; float* out;
    int tid, lane, wave, vcu, G;
};

__device__ __forceinline__ void tr_item(const float* W, int K, int Nsrc, bf16* WT, int src_col0, int dst_row0, int k0, const float* gk, LAS float* scr, int lane) {
#pragma unroll
    for (int i = 0; i < 32; ++i) { const int kk = 2 * i + (lane >> 5); float v = W[(size_t)(k0 + kk) * Nsrc + src_col0 + (lane & 31)]; if (gk) v *= gk[k0 + kk]; scr[kk * 33 + (lane & 31)] = v; }
    LDS_WAIT(); asm volatile("" ::: "memory");
    const int c = lane & 7;
#pragma unroll
    for (int j = 0; j < 4; ++j) { const int n = (lane >> 3) + 8 * j; const LAS float* s = scr + (8 * c) * 33 + n;
        v4u o; o.x = pk2(s[0 * 33], s[1 * 33]); o.y = pk2(s[2 * 33], s[3 * 33]); o.z = pk2(s[4 * 33], s[5 * 33]); o.w = pk2(s[6 * 33], s[7 * 33]);
        *(v4u*)(WT + (size_t)(dst_row0 + n) * K + k0 + 8 * c) = o; }
    LDS_WAIT(); asm volatile("" ::: "memory");
}
__device__ __forceinline__ float log_sigmoid(float x) { return x >= 0.f ? -log1pf(expf(-x)) : x - log1pf(expf(x)); }

__device__ __forceinline__ void norm_row(f32x4 (&v)[4], const f32x4 (&gv)[4], bf16* orow, const LAS float* wf, const float* bfg, float* lf, int lane) {
    float s = 0.f;
#pragma unroll
    for (int j = 0; j < 4; ++j) s += (v[j].x * v[j].x + v[j].y * v[j].y) + (v[j].z * v[j].z + v[j].w * v[j].w);
    const float rstd = rsqrtf(wave_sum(s) * (1.f / DM) + RMS_EPS);
    float fa[8];
#pragma unroll
    for (int q = 0; q < 8; ++q) fa[q] = 0.f;
    unsigned long long* o8 = (unsigned long long*)orow + lane;
#pragma unroll
    for (int j = 0; j < 4; ++j) { v[j] = v[j] * rstd * gv[j];
        o8[64 * j] = (unsigned long long)pk2(v[j].x, v[j].y) | ((unsigned long long)pk2(v[j].z, v[j].w) << 32);
#pragma unroll
        for (int e = 0; e < 4; ++e) { const LAS f32x4* wp = (const LAS f32x4*)(wf + (size_t)(256 * j + 4 * lane + e) * 8); const f32x4 w0 = wp[0], w1 = wp[1]; const float xv = v[j][e];
            fa[0] += xv * w0.x; fa[1] += xv * w0.y; fa[2] += xv * w0.z; fa[3] += xv * w0.w; fa[4] += xv * w1.x; fa[5] += xv * w1.y; fa[6] += xv * w1.z; fa[7] += xv * w1.w; } }
    const bool b5 = lane & 32, b4 = lane & 16, b3 = lane & 8;
    float k4[4], k2[2], k1;
#pragma unroll
    for (int i = 0; i < 4; ++i) { const float snd = b5 ? fa[i] : fa[4 + i], kp = b5 ? fa[4 + i] : fa[i]; k4[i] = kp + __shfl_xor(snd, 32); }
#pragma unroll
    for (int i = 0; i < 2; ++i) { const float snd = b4 ? k4[i] : k4[2 + i], kp = b4 ? k4[2 + i] : k4[i]; k2[i] = kp + __shfl_xor(snd, 16); }
    { const float snd = b3 ? k2[0] : k2[1], kp = b3 ? k2[1] : k2[0]; k1 = kp + __shfl_xor(snd, 8); }
    k1 += __shfl_xor(k1, 4); k1 += __shfl_xor(k1, 2); k1 += __shfl_xor(k1, 1);
    if ((lane & 7) == 0) { const int q = lane >> 3; lf[q] = log_sigmoid(k1 + bfg[q]); }
}

__device__ __forceinline__ void p0_prologue(Frame& F) {
    const int gw = F.vcu * 8 + F.wave, NGW = F.G * 8, lane = F.lane;
    const float* const* in = F.in;
    { float* z = (float*)(F.ws + WS_ROWSS1); for (int i = blockIdx.x * 512 + F.tid; i < 2 * 32768; i += F.G * 512) z[i] = 0.f; }
    { float* cp = (float*)(F.ws + WS_CP); for (int i = blockIdx.x * 512 + F.tid; i < FF * 8; i += F.G * 512) { const int c = i >> 3, k = i & 7, cc = c + (k >= 4 ? FF : 0), kk = k & 3; cp[i] = kk < 3 ? in[18][kk * FF2 + cc] : in[19][cc]; } }
    LAS float* wf = (LAS float*)(F.lds);
    for (int i = F.tid; i < 1024 * 8; i += 512) wf[i] = in[3][(size_t)(i >> 3) * INW + 1536 + (i & 7)];
    __syncthreads();
    LAS float* scr = (LAS float*)(F.lds + 32768 + F.wave * 9216);
    constexpr int I_IN = 16 * 128, I_A = 8 * 32, I_G = 8 * 64, I_O = 16 * 32, I_UP = 16 * 176, I_DN = 44 * 32;
    constexpr int NITEMS = I_IN + I_A + I_G + I_O + I_UP + I_DN;
    for (int it = gw; it < NITEMS; it += NGW) {
        int r = it;
        if (r < I_IN) { const int kb = r / 128, db = r % 128; tr_item(in[3], 1024, INW, (bf16*)(F.ws + WS_WIN), db < 48 ? 32 * db : 1544 + 32 * (db - 48), 32 * db, 64 * kb, nullptr, scr, lane); continue; } r -= I_IN;
        if (r < I_A) { const int kb = r / 32, db = r % 32; tr_item(in[5], 512, 1024, (bf16*)(F.ws + WS_WA), 32 * db, 32 * db, 64 * kb, nullptr, scr, lane); continue; } r -= I_A;
        if (r < I_G) { const int kb = r / 64, db = r % 64, pn = db >> 3, wi = db & 7; tr_item(in[14], 512, 2048, (bf16*)(F.ws + WS_WG), wi < 4 ? 128 * pn + 32 * wi : 1024 + 128 * pn + 32 * (wi - 4), 32 * db, 64 * kb, nullptr, scr, lane); continue; } r -= I_G;
        if (r < I_O) { const int kb = r / 32, db = r % 32; tr_item(in[15], 1024, 1024, (bf16*)(F.ws + WS_WO), 32 * db, 32 * db, 64 * kb, nullptr, scr, lane); continue; } r -= I_O;
        if (r < I_UP) { const int kb = r / 176, db = r % 176, pn = db >> 3, wi = db & 7; tr_item(in[17], 1024, FF2, (bf16*)(F.ws + WS_WUP), wi < 4 ? 128 * pn + 32 * wi : FF + 128 * pn + 32 * (wi - 4), 32 * db, 64 * kb, in[16], scr, lane); continue; } r -= I_UP;
        { const int kb = r / 32, db = r % 32; tr_item(in[20], FF, 1024, (bf16*)(F.ws + WS_WDN), 32 * db, 32 * db, 64 * kb, nullptr, scr, lane); }
    }
    f32x4 gv[4];
#pragma unroll
    for (int j = 0; j < 4; ++j) gv[j] = ((const f32x4*)in[2])[lane + 64 * j];
    bf16* XN = (bf16*)(F.ws + WS_RA); float* LOGF = (float*)(F.ws + WS_LOGF);
    {   f32x4 vn[4];
        auto rowptr = [&](int m) -> const f32x4* { return (const f32x4*)(m < MROWS ? in[0] + (size_t)m * DM : in[1] + (size_t)(m - MROWS) * DM) + lane; };
        if (gw < MROWS + NMETA) { const f32x4* xr = rowptr(gw);
#pragma unroll
            for (int j = 0; j < 4; ++j) vn[j] = xr[64 * j]; }
        for (int m = gw; m < MROWS + NMETA; m += NGW) {
            f32x4 v[4];
#pragma unroll
            for (int j = 0; j < 4; ++j) v[j] = vn[j];
            if (m + NGW < MROWS + NMETA) { const f32x4* xr = rowptr(m + NGW);
#pragma unroll
                for (int j = 0; j < 4; ++j) vn[j] = xr[64 * j]; }
            if (m < MROWS) norm_row(v, gv, XN + (size_t)m * DM, wf, in[4], LOGF + (size_t)m * 8, lane);
            else { const int r = m - MROWS; norm_row(v, gv, (bf16*)(F.ws + WS_XNM) + (size_t)r * DM, wf, in[4], (float*)(F.ws + WS_LOGFM) + r * 8, lane); }
        }
    }
}

__device__ __forceinline__ f32x4 skinny_tile(const bf16* A, const bf16* Bt, int K, int ct, int lane) {
    const bf16* ap = A + (size_t)(lane & 15) * K + 8 * (lane >> 4);
    const bf16* bp = Bt + (size_t)(16 * ct + (lane & 15)) * K + 8 * (lane >> 4);
    f32x4 acc = {0.f, 0.f, 0.f, 0.f};
    for (int s = 0; s < K / 32; s += 16) {
        bf16x8 a[16], b[16];
#pragma unroll
        for (int q = 0; q < 16; ++q) { a[q] = *(const bf16x8*)(ap + 32 * (s + q)); b[q] = *(const bf16x8*)(bp + 32 * (s + q)); }
#pragma unroll
        for (int q = 0; q < 16; ++q) acc = __builtin_amdgcn_mfma_f32_16x16x32_bf16(a[q], b[q], acc, 0, 0, 0);
    }
    return acc;
}
template <int MODE>
__device__ __forceinline__ f32x4 skinny2(const void* X0, const void* X1, const bf16* Bt, int K, int ct, int lane) {
    const int row = lane & 15, ko = 8 * (lane >> 4); const bool live = row < 2;
    const bf16* bp = Bt + (size_t)(16 * ct + row) * K + ko;
    f32x4 acc = {0.f, 0.f, 0.f, 0.f};
    for (int s = 0; s < K / 32; s += 16) {
        bf16x8 a[16], b[16];
#pragma unroll
        for (int q = 0; q < 16; ++q) { b[q] = *(const bf16x8*)(bp + 32 * (s + q));
            v4u w = {0u, 0u, 0u, 0u};
            if (live) { const size_t o = (size_t)row * K + ko + 32 * (s + q);
                if (MODE == 0) w = *(const v4u*)((const bf16*)X0 + o);
                else { f32x4 p0 = *(const f32x4*)((const float*)X0 + o), p1 = *(const f32x4*)((const float*)X0 + o + 4);
                    if (MODE == 1) { p0 = p0 + *(const f32x4*)((const float*)X1 + o); p1 = p1 + *(const f32x4*)((const float*)X1 + o + 4); }
                    w.x = pk2(p0.x, p0.y); w.y = pk2(p0.z, p0.w); w.z = pk2(p1.x, p1.y); w.w = pk2(p1.z, p1.w); } }
            a[q] = __builtin_bit_cast(bf16x8, w); }
#pragma unroll
        for (int q = 0; q < 16; ++q) acc = __builtin_amdgcn_mfma_f32_16x16x32_bf16(a[q], b[q], acc, 0, 0, 0);
    }
    return acc;
}

__device__ __forceinline__ void p1_extras(Frame& F) {
    const int gw = F.vcu * 8 + F.wave, NGW = F.G * 8, lane = F.lane;
    for (int ct = gw; ct < 256; ct += NGW) {
        const f32x4 acc = skinny_tile((const bf16*)(F.ws + WS_XNM), (const bf16*)(F.ws + WS_WIN), 1024, ct, lane);
        const int col = 16 * ct + (lane & 15), fq = lane >> 4;
#pragma unroll
        for (int i = 0; i < 4; ++i) { const int r = 4 * fq + i;
            if (col < 2048) ((bf16*)(F.ws + WS_QKVUM))[(size_t)(col >> 9) * (16 * 512) + r * 512 + (col & 511)] = (bf16)(pk2(acc[i], 0.f) & 0xffffu);
            else ((bf16*)(F.ws + WS_GATEM))[r * 2048 + (col - 2048)] = (bf16)(pk2(fsigm(acc[i]), 0.f) & 0xffffu); }
    }
    const float* LOGF = (const float*)(F.ws + WS_LOGF); const float* LOGFM = (const float*)(F.ws + WS_LOGFM); float* CUMF = (float*)(F.ws + WS_CUMF);
    for (int sq = gw; sq < NB * NH; sq += NGW) { const int b = sq >> 3, h = sq & 7; float carry = 0.f;
        for (int p0 = 0; p0 < LTOT; p0 += 64) { const int p = p0 + lane;
            float v = 0.f; if (p < LTOT) v = p < NMETA ? LOGFM[p * 8 + h] : LOGF[(size_t)(b * SEQ + p - NMETA) * 8 + h];
#pragma unroll
            for (int o = 1; o < 64; o <<= 1) { const float t = __shfl_up(v, o); if (lane >= o) v += t; }
            v += carry; if (p < LTOT) CUMF[(size_t)sq * LTOT + p] = v; carry = __shfl(v, 63); } }
}

struct S5Regs { float l0r, l0i, l1r, l1i; bf16x8 Bf[4]; bf16x8 Cm[4]; float dsk; };
__device__ __forceinline__ void cw_sincos(float x, float& s, float& c) { s = sinf(x); c = cosf(x); }
__device__ __forceinline__ void s5_setup(const float* const* in, int g, int lane, S5Regs& R) {
    const int j = lane & 31, kq5 = lane >> 5;
    const float dt = expf(in[13][g]);
#pragma unroll
    for (int wh = 0; wh < 2; ++wh) { const int p = j + 32 * wh;
        const float lr = in[6][g * 64 + p], li = in[7][g * 64 + p];
        const float a = lr * dt, b = li * dt, ea = expf(a); float sb, cb; cw_sincos(b, sb, cb);
        const float lbr = ea * cb, lbi = ea * sb;
        const float sh = sinf(0.5f * b), nre = expm1f(a) * cb - 2.f * sh * sh, nim = ea * sb;
        const float den = 1.0f / (lr * lr + li * li), cre = (nre * lr + nim * li) * den, cim = (nim * lr - nre * li) * den;
        const f32x4* br = (const f32x4*)(in[8] + ((size_t)(g * 64 + p) * 16 + 8 * kq5)); const f32x4* bi = (const f32x4*)(in[9] + ((size_t)(g * 64 + p) * 16 + 8 * kq5));
        const f32x4 r0 = br[0], r1 = br[1], i0 = bi[0], i1 = bi[1];
        v4u re, im;
        re.x = pk2(cre * r0.x - cim * i0.x, cre * r0.y - cim * i0.y); re.y = pk2(cre * r0.z - cim * i0.z, cre * r0.w - cim * i0.w);
        re.z = pk2(cre * r1.x - cim * i1.x, cre * r1.y - cim * i1.y); re.w = pk2(cre * r1.z - cim * i1.z, cre * r1.w - cim * i1.w);
        im.x = pk2(cre * i0.x + cim * r0.x, cre * i0.y + cim * r0.y); im.y = pk2(cre * i0.z + cim * r0.z, cre * i0.w + cim * r0.w);
        im.z = pk2(cre * i1.x + cim * r1.x, cre * i1.y + cim * r1.y); im.w = pk2(cre * i1.z + cim * r1.z, cre * i1.w + cim * r1.w);
        R.Bf[2 * wh] = __builtin_bit_cast(bf16x8, re); R.Bf[2 * wh + 1] = __builtin_bit_cast(bf16x8, im);
        if (wh == 0) { R.l0r = lbr; R.l0i = lbi; } else { R.l1r = lbr; R.l1i = lbi; } }
    const int c = lane & 15, kq = lane >> 4;
    const float* cr = in[10] + (size_t)(g * 16 + c) * 64; const float* ci = in[11] + (size_t)(g * 16 + c) * 64;
#pragma unroll
    for (int s = 0; s < 4; ++s) { const int ja = 8 * s + 2 * kq, jb = ja + 1; v4u w;
        w.x = pk2(cr[ja], -ci[ja]); w.y = pk2(cr[ja + 32], -ci[ja + 32]); w.z = pk2(cr[jb], -ci[jb]); w.w = pk2(cr[jb + 32], -ci[jb + 32]);
        R.Cm[s] = __builtin_bit_cast(bf16x8, w); }
    R.dsk = in[12][g * 16 + c];
}
constexpr int S5_XP = 136;
template <bool FULL, class ZST>
__device__ __forceinline__ void s5_chunk(const S5Regs& R, const bf16x8 a, float (&x)[4], LAS bf16* X, LAS bf16* Ut, int lane, const ZST& zst) {
    f32x16 bu[4];
    const f32x16 zero = {0.f, 0.f, 0.f, 0.f, 0.f, 0.f, 0.f, 0.f, 0.f, 0.f, 0.f, 0.f, 0.f, 0.f, 0.f, 0.f};
#pragma unroll
    for (int q = 0; q < 4; ++q) bu[q] = __builtin_amdgcn_mfma_f32_32x32x16_bf16(a, R.Bf[q], zero, 0, 0, 0);
    const int j = lane & 31, hi = lane >> 5;
    if (FULL) { const int i = lane & 31, th = (i >> 2) & 1, r = (i & 3) + 4 * (i >> 3); *(LAS bf16x8*)(Ut + (16 * th + r) * 16 + 8 * hi) = a; }
#pragma unroll
    for (int r = 0; r < 16; ++r) {
        const float n0r = fmaf(R.l0r, x[0], fmaf(-R.l0i, x[1], bu[0][r])), n0i = fmaf(R.l0r, x[1], fmaf(R.l0i, x[0], bu[1][r]));
        const float n1r = fmaf(R.l1r, x[2], fmaf(-R.l1i, x[3], bu[2][r])), n1i = fmaf(R.l1r, x[3], fmaf(R.l1i, x[2], bu[3][r]));
        x[0] = n0r; x[1] = n0i; x[2] = n1r; x[3] = n1i;
        if (FULL) { v2u w; w.x = pk2(n0r, n0i); w.y = pk2(n1r, n1i); *(LAS v2u*)(X + (16 * hi + r) * S5_XP + 4 * j) = w; }
    }
    if (FULL) {
        LDS_WAIT(); asm volatile("" ::: "memory");
        const int c = lane & 15, fq = lane >> 4;
#pragma unroll
        for (int th = 0; th < 2; ++th) { f32x4 acc = {0.f, 0.f, 0.f, 0.f};
#pragma unroll
            for (int s = 0; s < 4; ++s) { const bf16x8 xa = *(const LAS bf16x8*)(X + (16 * th + c) * S5_XP + 32 * s + 8 * fq); acc = __builtin_amdgcn_mfma_f32_16x16x32_bf16(xa, R.Cm[s], acc, 0, 0, 0); }
#pragma unroll
            for (int i = 0; i < 4; ++i) { const int r = 4 * fq + i; const float y = acc[i] + R.dsk * bf2f(Ut[(16 * th + r) * 16 + c]);
                const float uu = 0.7978845608028654f * (y + 0.044715f * y * y * y); zst(th, r, c, y * fsigm(2.f * uu)); } }
        LDS_WAIT(); asm volatile("" ::: "memory");
    }
}
struct ZNone { __device__ __forceinline__ void operator()(int, int, int, float) const {} };
struct ZMain { bf16* z0; bf16* z1; __device__ __forceinline__ void operator()(int th, int r, int c, float v) const { (th ? z1 : z0)[(size_t)r * 512 + c] = (bf16)(pk2(v, 0.f) & 0xffffu); } };
struct ZMeta { bf16* za; __device__ __forceinline__ void operator()(int th, int r, int c, float v) const { if (th == 0 && r >= 14) za[(r - 14) * 512 + c] = (bf16)(pk2(v, 0.f) & 0xffffu); } };

__device__ __forceinline__ void s5_unit(Frame& F, int g, int bp) {
    const int lane = F.lane, w = F.wave;
    LAS bf16* X = (LAS bf16*)(F.lds + w * 10240); LAS bf16* Ut = (LAS bf16*)(F.lds + w * 10240 + 8704);
    LAS float* Ex = (LAS float*)(F.lds + 81920);
    S5Regs R; s5_setup(F.in, g, lane, R);
    const bf16* U = (const bf16*)(F.ws + WS_QKVU) + (size_t)3 * MROWS * 512; const bf16* UM = (const bf16*)(F.ws + WS_QKVUM) + 3 * 16 * 512;
    bf16* Z = (bf16*)(F.ws + WS_RB + 32 * MiB);
    const int i = lane & 31, kq5 = lane >> 5, th = (i >> 2) & 1, r = (i & 3) + 4 * (i >> 3);
    const bf16* upm = UM + r * 512 + 16 * g + 8 * kq5;
    const int t0 = 256 * w;
    const bf16* up0 = U + ((size_t)((2 * bp + th) * SEQ + t0 + r)) * 512 + 16 * g + 8 * kq5;
    float x[4] = {0.f, 0.f, 0.f, 0.f}; float xm[4] = {0.f, 0.f, 0.f, 0.f};
    if (w == 0) { s5_chunk<false>(R, *(const bf16x8*)upm, x, X, Ut, lane, ZNone{}); xm[0] = x[0]; xm[1] = x[1]; xm[2] = x[2]; xm[3] = x[3]; }
    { bf16x8 an = *(const bf16x8*)up0;
      for (int c = 0; c < 16; ++c) { const bf16x8 ac = an; if (c < 15) an = *(const bf16x8*)(up0 + (size_t)(c + 1) * 16 * 512); s5_chunk<false>(R, ac, x, X, Ut, lane, ZNone{}); } }
    *(LAS f32x4*)(Ex + (w * 64 + lane) * 4) = (f32x4){x[0], x[1], x[2], x[3]};
    __syncthreads();
    float p0r = R.l0r, p0i = R.l0i, p1r = R.l1r, p1i = R.l1i;
#pragma unroll
    for (int q = 0; q < 8; ++q) { const float a = p0r * p0r - p0i * p0i, b = 2.f * p0r * p0i, c2 = p1r * p1r - p1i * p1i, d = 2.f * p1r * p1i; p0r = a; p0i = b; p1r = c2; p1i = d; }
    if (w == 0) { x[0] = xm[0]; x[1] = xm[1]; x[2] = xm[2]; x[3] = xm[3]; }
    else { f32x4 e = *(const LAS f32x4*)(Ex + lane * 4);
        for (int v = 1; v < w; ++v) { const f32x4 ev = *(const LAS f32x4*)(Ex + (v * 64 + lane) * 4);
            const float a = ev[0] + p0r * e[0] - p0i * e[1], b = ev[1] + p0r * e[1] + p0i * e[0], c2 = ev[2] + p1r * e[2] - p1i * e[3], d = ev[3] + p1r * e[3] + p1i * e[2]; e = (f32x4){a, b, c2, d}; }
        x[0] = e[0]; x[1] = e[1]; x[2] = e[2]; x[3] = e[3]; }
    { bf16x8 an = *(const bf16x8*)up0;
      for (int c = 0; c < 16; ++c) { const int t = t0 + 16 * c; const bf16x8 ac = an; if (c < 15) an = *(const bf16x8*)(up0 + (size_t)(c + 1) * 16 * 512);
        ZMain zs{Z + ((size_t)((2 * bp) * SEQ + t)) * 512 + 16 * g, Z + ((size_t)((2 * bp + 1) * SEQ + t)) * 512 + 16 * g};
        s5_chunk<true>(R, ac, x, X, Ut, lane, zs); } }
    __syncthreads();
}

__device__ __forceinline__ void meta_p2(Frame& F) {
    const int tid = F.tid, lane = F.lane, w = F.wave, gw = F.vcu * 8 + w;
    bf16* aA = (bf16*)(F.ws + WS_AA); bf16* zA = (bf16*)(F.ws + WS_ZA);
    const bf16* QM = (const bf16*)(F.ws + WS_QKVUM); const bf16* KM = QM + 16 * 512; const bf16* VM = KM + 16 * 512; const bf16* UM = VM + 16 * 512;
    const float* LOGFM = (const float*)(F.ws + WS_LOGFM);
    if (gw < NG) { LAS bf16* X = (LAS bf16*)(F.lds + w * 10240); LAS bf16* Ut = (LAS bf16*)(F.lds + w * 10240 + 8704);
        const int i = lane & 31, kq5 = lane >> 5, r = (i & 3) + 4 * (i >> 3), g = gw;
        S5Regs R; s5_setup(F.in, g, lane, R); float x[4] = {0.f, 0.f, 0.f, 0.f};
        s5_chunk<true>(R, *(const bf16x8*)(UM + r * 512 + 16 * g + 8 * kq5), x, X, Ut, lane, ZMeta{zA + 16 * g}); }
    if (F.vcu == (F.G > 4 ? 4 : 0)) {
        LAS float* PM = (LAS float*)(F.lds + 98304);
        __syncthreads();
        if (tid < 256) { const int h = tid >> 5, qi = (tid >> 4) & 1, key = tid & 15, qp = 14 + qi;
            float s = 0.f;
            for (int d = 0; d < 64; ++d) s += bf2f(QM[qp * 512 + 64 * h + d]) * bf2f(KM[key * 512 + 64 * h + d]);
            float fq = 0.f, fk = 0.f;
            for (int p = 0; p < 16; ++p) { const float lf = LOGFM[p * 8 + h]; if (p <= qp) fq += lf; if (p <= key) fk += lf; }
            s = s * 0.125f + fq - fk; if (key > qp) s = -1e30f;
            float mx = s;
#pragma unroll
            for (int o = 1; o < 16; o <<= 1) mx = fmaxf(mx, __shfl_xor(mx, o));
            float p = expf(s - mx), sum = p;
#pragma unroll
            for (int o = 1; o < 16; o <<= 1) sum += __shfl_xor(sum, o);
            PM[(h * 2 + qi) * 16 + key] = p / sum; }
        __syncthreads();
        for (int o = tid; o < 1024; o += 512) { const int qi = o >> 9, col = o & 511, h = col >> 6; float a = 0.f;
            for (int k = 0; k < 16; ++k) a += PM[(h * 2 + qi) * 16 + k] * bf2f(VM[k * 512 + col]);
            aA[qi * 512 + col] = (bf16)(pk2(a, 0.f) & 0xffffu); }
        __syncthreads();
    }
}
__device__ __forceinline__ void meta_p3(Frame& F) {
    const int lane = F.lane, gw = F.vcu * 8 + F.wave;
    const bf16* GM = (const bf16*)(F.ws + WS_GATEM); float* YA = (float*)(F.ws + WS_MA); float* GY = YA + 2048;
    if (gw < 64) { const int ct = gw; const f32x4 acc = skinny2<0>(F.ws + WS_AA, nullptr, (const bf16*)(F.ws + WS_WA), 512, ct, lane);
        if (lane < 16) { const int col = 16 * ct + lane; YA[col] = acc[0] * bf2f(GM[14 * 2048 + col]); YA[1024 + col] = acc[1] * bf2f(GM[15 * 2048 + col]); } }
    else if (gw < 128) { const int pi = gw - 64, pn = pi >> 3, wi = pi & 7;
        const f32x4 av = skinny2<0>(F.ws + WS_ZA, nullptr, (const bf16*)(F.ws + WS_WG), 512, 16 * pn + wi, lane), ag = skinny2<0>(F.ws + WS_ZA, nullptr, (const bf16*)(F.ws + WS_WG), 512, 16 * pn + 8 + wi, lane);
        if (lane < 16) { const int ch = 128 * pn + 16 * wi + lane;
            GY[ch] = bf2f(GM[14 * 2048 + 1024 + ch]) * av[0] * fsigm(ag[0]); GY[1024 + ch] = bf2f(GM[15 * 2048 + 1024 + ch]) * av[1] * fsigm(ag[1]); } }
}
__device__ __forceinline__ void meta_p4(Frame& F) {
    const int lane = F.lane, gw = F.vcu * 8 + F.wave;
    const float* YA = (const float*)(F.ws + WS_MA); float* H1M = (float*)(F.ws + WS_HA);
    if (gw < 64) { const int ct = gw; const f32x4 acc = skinny2<1>(YA, YA + 2048, (const bf16*)(F.ws + WS_WO), 1024, ct, lane);
        if (lane < 16) { const int col = 16 * ct + lane; H1M[col] = F.in[1][14 * 1024 + col] + acc[0]; H1M[1024 + col] = F.in[1][15 * 1024 + col] + acc[1]; } }
}
__device__ __forceinline__ void meta_p5(Frame& F) {
    const int lane = F.lane, gw = F.vcu * 8 + F.wave, NGW = F.G * 8;
    const float* H1M = (const float*)(F.ws + WS_HA); float* EM = (float*)(F.ws + WS_EDGEM);
    for (int ct = gw; ct < 352; ct += NGW) {
        float s0 = 0.f, s1 = 0.f;
#pragma unroll
        for (int q = 0; q < 4; ++q) { const f32x4 a = ((const f32x4*)H1M)[lane + 64 * q], b = ((const f32x4*)(H1M + 1024))[lane + 64 * q];
            s0 += (a.x * a.x + a.y * a.y) + (a.z * a.z + a.w * a.w); s1 += (b.x * b.x + b.y * b.y) + (b.z * b.z + b.w * b.w); }
        const float r0 = rsqrtf(wave_sum(s0) * (1.f / 1024.f) + RMS_EPS), r1 = rsqrtf(wave_sum(s1) * (1.f / 1024.f) + RMS_EPS);
        const f32x4 acc = skinny2<2>(H1M, nullptr, (const bf16*)(F.ws + WS_WUP), 1024, ct, lane);
        if (lane < 16) { const int pn = ct >> 4, wi = ct & 15; const int hc = wi < 8 ? 128 * pn + 16 * wi + lane : FF + 128 * pn + 16 * (wi - 8) + lane;
            EM[hc] = r0 * acc[0]; EM[FF2 + hc] = r1 * acc[1]; } }
}

__device__ __forceinline__ int crow(int r, int hi) { return (r & 3) + 8 * (r >> 2) + 4 * hi; }
constexpr int AT_KP = 72, AT_VP = 68, AT_BUF = 64 * AT_KP * 2 + 64 * AT_VP * 2 + 256;
__device__ __forceinline__ void attn_unit(Frame& F, int b, int h, int qb) {
    const int tid = F.tid, lane = F.lane, w = F.wave, q = lane & 31, hi = lane >> 5;
    const bf16* Q = (const bf16*)(F.ws + WS_QKVU); const bf16* K = Q + (size_t)MROWS * 512; const bf16* V = K + (size_t)MROWS * 512;
    const bf16* KM = (const bf16*)(F.ws + WS_QKVUM) + 16 * 512; const bf16* VM = KM + 16 * 512;
    const float* CF = (const float*)(F.ws + WS_CUMF) + (size_t)(b * 8 + h) * LTOT;
    bf16* ATT = (bf16*)(F.ws + WS_RB);
    const int t0w = 256 * qb + 32 * w, pq = NMETA + t0w + q;
    const size_t rowq = (size_t)b * SEQ + t0w + q;
    bf16x8 Qf[4];
#pragma unroll
    for (int s = 0; s < 4; ++s) Qf[s] = *(const bf16x8*)(Q + rowq * 512 + 64 * h + 16 * s + 8 * hi);
    const float Fq = CF[pq] * LOG2E;
    const int ntiles = 4 * qb + 5, jmax = 4 * qb + ((32 * w + 47) >> 6);
    float mrun = -1e30f, lrun = 0.f;
    f32x16 O0, O1;
#pragma unroll
    for (int r = 0; r < 16; ++r) { O0[r] = 0.f; O1[r] = 0.f; }
    const int skey = tid >> 3, sch = tid & 7;
    v4u kreg, vreg; float fkreg = 0.f;
#define AT_LOAD(jt) do { const int p_ = 64 * (jt) + skey; const bf16 *kp_, *vp_; \
        if (p_ < NMETA) { kp_ = KM + p_ * 512; vp_ = VM + p_ * 512; } else { int rr_ = p_ - NMETA; rr_ = rr_ > SEQ - 1 ? SEQ - 1 : rr_; kp_ = K + ((size_t)b * SEQ + rr_) * 512; vp_ = V + ((size_t)b * SEQ + rr_) * 512; } \
        kreg = *(const v4u*)(kp_ + 64 * h + 8 * sch); vreg = *(const v4u*)(vp_ + 64 * h + 8 * sch); \
        if (tid < 64) { int pf_ = 64 * (jt) + tid; pf_ = pf_ > LTOT - 1 ? LTOT - 1 : pf_; fkreg = CF[pf_] * LOG2E; } } while (0)
    AT_LOAD(0);
    for (int jt = 0; jt < ntiles; ++jt) {
        LAS unsigned char* buf = F.lds + (jt & 1) * AT_BUF;
        LAS bf16* Ks = (LAS bf16*)buf; LAS bf16* Vt = (LAS bf16*)(buf + 64 * AT_KP * 2); LAS float* Fk = (LAS float*)(buf + 64 * AT_KP * 2 + 64 * AT_VP * 2);
        *(LAS v4u*)(Ks + skey * AT_KP + 8 * sch) = kreg;
        { const unsigned vv[4] = {vreg.x, vreg.y, vreg.z, vreg.w};
#pragma unroll
          for (int e = 0; e < 4; ++e) { Vt[(8 * sch + 2 * e) * AT_VP + skey] = (bf16)(vv[e] & 0xffffu); Vt[(8 * sch + 2 * e + 1) * AT_VP + skey] = (bf16)(vv[e] >> 16); } }
        if (tid < 64) Fk[tid] = fkreg;
        __syncthreads();
        if (jt + 1 < ntiles) AT_LOAD(jt + 1);
        if (jt <= jmax) {
            f32x16 p0, p1;
#pragma unroll
            for (int r = 0; r < 16; ++r) { p0[r] = 0.f; p1[r] = 0.f; }
#pragma unroll
            for (int s = 0; s < 4; ++s) {
                const bf16x8 k0 = *(const LAS bf16x8*)(Ks + q * AT_KP + 16 * s + 8 * hi), k1 = *(const LAS bf16x8*)(Ks + (32 + q) * AT_KP + 16 * s + 8 * hi);
                p0 = __builtin_amdgcn_mfma_f32_32x32x16_bf16(k0, Qf[s], p0, 0, 0, 0); p1 = __builtin_amdgcn_mfma_f32_32x32x16_bf16(k1, Qf[s], p1, 0, 0, 0); }
            const bool need_mask = (64 * jt + 63) > (NMETA + t0w);
            float mx = -1e30f;
#pragma unroll
            for (int g4 = 0; g4 < 4; ++g4) { const f32x4 f0 = *(const LAS f32x4*)(Fk + 8 * g4 + 4 * hi), f1 = *(const LAS f32x4*)(Fk + 32 + 8 * g4 + 4 * hi);
#pragma unroll
                for (int e = 0; e < 4; ++e) { const int r = 4 * g4 + e;
                    float a = fmaf(p0[r], 0.125f * LOG2E, Fq - f0[e]), c = fmaf(p1[r], 0.125f * LOG2E, Fq - f1[e]);
                    if (need_mask) { const int pk = 64 * jt + 8 * g4 + 4 * hi + e; if (pk > pq) a = -1e30f; if (pk + 32 > pq) c = -1e30f; }
                    p0[r] = a; p1[r] = c; mx = fmaxf(mx, fmaxf(a, c)); } }
            mx = fmaxf(mx, __shfl_xor(mx, 32));
            const float mnew = fmaxf(mrun, mx), alpha = __builtin_amdgcn_exp2f(mrun - mnew); mrun = mnew;
            float ps = 0.f;
#pragma unroll
            for (int r = 0; r < 16; ++r) { p0[r] = __builtin_amdgcn_exp2f(p0[r] - mnew); p1[r] = __builtin_amdgcn_exp2f(p1[r] - mnew); ps += p0[r] + p1[r]; }
            lrun = lrun * alpha + ps;
#pragma unroll
            for (int r = 0; r < 16; ++r) { O0[r] *= alpha; O1[r] *= alpha; }
#pragma unroll
            for (int t = 0; t < 4; ++t) {
                v4u pw;
                if (t < 2) { const int o = 8 * (t & 1); pw.x = pk2(p0[o], p0[o + 1]); pw.y = pk2(p0[o + 2], p0[o + 3]); pw.z = pk2(p0[o + 4], p0[o + 5]); pw.w = pk2(p0[o + 6], p0[o + 7]); }
                else { const int o = 8 * (t & 1); pw.x = pk2(p1[o], p1[o + 1]); pw.y = pk2(p1[o + 2], p1[o + 3]); pw.z = pk2(p1[o + 4], p1[o + 5]); pw.w = pk2(p1[o + 6], p1[o + 7]); }
                const bf16x8 pb = __builtin_bit_cast(bf16x8, pw);
                const int key0 = 32 * (t >> 1) + 16 * (t & 1) + 4 * hi;
                const v2u a0 = *(const LAS v2u*)(Vt + q * AT_VP + key0), a1 = *(const LAS v2u*)(Vt + q * AT_VP + key0 + 8);
                const v2u b0 = *(const LAS v2u*)(Vt + (32 + q) * AT_VP + key0), b1 = *(const LAS v2u*)(Vt + (32 + q) * AT_VP + key0 + 8);
                const v4u va = {a0.x, a0.y, a1.x, a1.y}, vb = {b0.x, b0.y, b1.x, b1.y};
                O0 = __builtin_amdgcn_mfma_f32_32x32x16_bf16(__builtin_bit_cast(bf16x8, va), pb, O0, 0, 0, 0);
                O1 = __builtin_amdgcn_mfma_f32_32x32x16_bf16(__builtin_bit_cast(bf16x8, vb), pb, O1, 0, 0, 0);
            }
        }
    }
#undef AT_LOAD
    const float inv = 1.0f / (lrun + __shfl_xor(lrun, 32));
    bf16* op = ATT + rowq * 512 + 64 * h;
#pragma unroll
    for (int g4 = 0; g4 < 4; ++g4) { v2u w0, w1;
        w0.x = pk2(O0[4 * g4] * inv, O0[4 * g4 + 1] * inv); w0.y = pk2(O0[4 * g4 + 2] * inv, O0[4 * g4 + 3] * inv);
        w1.x = pk2(O1[4 * g4] * inv, O1[4 * g4 + 1] * inv); w1.y = pk2(O1[4 * g4 + 2] * inv, O1[4 * g4 + 3] * inv);
        *(v2u*)(op + 8 * g4 + 4 * hi) = w0; *(v2u*)(op + 32 + 8 * g4 + 4 * hi) = w1; }
    __syncthreads();
}

__device__ __forceinline__ void p6_fixup(Frame& F) {
    const float* EDGE = (const float*)(F.ws + WS_EDGE); const float* EM = (const float*)(F.ws + WS_EDGEM);
    const float* CP = (const float*)(F.ws + WS_CP); bf16* ACT = (bf16*)(F.ws + WS_ACT);
    const int total = 512 * 2 * (FF / 4);
    for (int i = blockIdx.x * 512 + F.tid; i < total; i += F.G * 512) {
        const int c4 = (i % (FF / 4)) * 4, rr = (i / (FF / 4)) & 1, rb = i / (2 * (FF / 4));
        const bool first = (rb & 31) == 0;
        float o[4];
#pragma unroll
        for (int e = 0; e < 4; ++e) { const int c = c4 + e;
            const float* e0 = EDGE + ((size_t)rb * FF + c) * 8; const float* ep = EDGE + ((size_t)(rb - 1) * FF + c) * 8;
            float v2, v1, v0, g2, g1, g0;
            if (rr == 0) { v0 = e0[0]; g0 = e0[4];
                if (first) { v2 = EM[c]; g2 = EM[FF + c]; v1 = EM[FF2 + c]; g1 = EM[FF2 + FF + c]; } else { v2 = ep[2]; g2 = ep[6]; v1 = ep[3]; g1 = ep[7]; } }
            else { v0 = e0[1]; g0 = e0[5]; v1 = e0[0]; g1 = e0[4];
                if (first) { v2 = EM[FF2 + c]; g2 = EM[FF2 + FF + c]; } else { v2 = ep[3]; g2 = ep[7]; } }
            const float* cp = CP + c * 8;
            const float ov = cp[3] + cp[0] * v2 + cp[1] * v1 + cp[2] * v0;
            const float og = cp[7] + cp[4] * g2 + cp[5] * g1 + cp[6] * g0;
            o[e] = og * fsigm(og) * ov; }
        v2u w; w.x = pk2(o[0], o[1]); w.y = pk2(o[2], o[3]);
        *(v2u*)(ACT + (size_t)(64 * rb + rr) * FF + c4) = w;
    }
}

__device__ __forceinline__ void p8_final(Frame& F) {
    const int gw = F.vcu * 8 + F.wave, NGW = F.G * 8, lane = F.lane;
    const float* rowss = (const float*)(F.ws + WS_ROWSS2);
    f32x4 gv[4];
#pragma unroll
    for (int j = 0; j < 4; ++j) gv[j] = ((const f32x4*)F.in[21])[lane + 64 * j];
    f32x4 vn[4]; float rn = 0.f;
    if (gw < MROWS) { const f32x4* o = (const f32x4*)(F.out + (size_t)gw * DM) + lane; rn = rowss[gw];
#pragma unroll
        for (int j = 0; j < 4; ++j) vn[j] = o[64 * j]; }
    for (int m = gw; m < MROWS; m += NGW) { f32x4 v[4]; const float rc = rn;
#pragma unroll
        for (int j = 0; j < 4; ++j) v[j] = vn[j];
        if (m + NGW < MROWS) { const f32x4* o = (const f32x4*)(F.out + (size_t)(m + NGW) * DM) + lane; rn = rowss[m + NGW];
#pragma unroll
            for (int j = 0; j < 4; ++j) vn[j] = o[64 * j]; }
        const float rstd = rsqrtf(rc * (1.f / DM) + RMS_EPS); f32x4* o = (f32x4*)(F.out + (size_t)m * DM) + lane;
#pragma unroll
        for (int j = 0; j < 4; ++j) o[64 * j] = v[j] * rstd * gv[j]; }
}

#define XB_TMO      128
#define XB_XCNT(j)  (256  + 64 * (j))
#define XB_XSUB(j)  (1280 + 64 * (j))
#define XB_XGEN(j)  (2304 + 64 * (j))
#define XB_TOP      3328
#define XB_TOPGEN   3392
#define XCD_BAR_WORDS 3456
#define XB_SPIN_CAP (1u << 18)

__device__ __forceinline__ unsigned xb_ld(unsigned* p)              { return __hip_atomic_load(p, __ATOMIC_RELAXED, __HIP_MEMORY_SCOPE_AGENT); }
__device__ __forceinline__ unsigned xb_add(unsigned* p, unsigned v) { return __hip_atomic_fetch_add(p, v, __ATOMIC_RELAXED, __HIP_MEMORY_SCOPE_AGENT); }
__device__ __forceinline__ unsigned xb_xcc_id() { return (unsigned)__builtin_amdgcn_s_getreg((3 << 11) | 20) & 0xFu; }
#define XB_SPIN(cond, bar) do { unsigned _sp = 0; while (cond) { __builtin_amdgcn_s_sleep(1); \
    if ((++_sp & 255u) == 0u) { if (xb_ld(&(bar)[XB_TMO])) break; if (_sp > XB_SPIN_CAP) { atomicAdd(&(bar)[XB_TMO], 1u); break; } } } } while (0)

struct XcdBarrier {
    unsigned* bar; unsigned x;
    volatile LAS unsigned* st;
};

__device__ __forceinline__ XcdBarrier xcd_barrier_post(unsigned* bar, volatile LAS unsigned* st) {
    XcdBarrier b; b.bar = bar; b.x = xb_xcc_id(); b.st = st;
    if (threadIdx.x == 0) (void)xb_add(&bar[XB_XCNT(b.x)], 1u);
    return b;
}
__device__ __forceinline__ void xcd_barrier_complete(unsigned* bar, unsigned x, unsigned& nloc, unsigned& nx) {
    const unsigned G = gridDim.x * gridDim.y * gridDim.z;
    unsigned sum, cnt, mine, sp = 0u;
    for (;;) {
        sum = 0u; cnt = 0u; mine = 0u;
#pragma unroll
        for (unsigned j = 0; j < 16; ++j) { const unsigned c = xb_ld(&bar[XB_XCNT(j)]); sum += c; cnt += (c > 0u) ? 1u : 0u; mine = (j == x) ? c : mine; }
        if (sum == G) break;
        __builtin_amdgcn_s_sleep(1);
        if ((++sp & 255u) == 0u) { if (xb_ld(&bar[XB_TMO])) break; if (sp > XB_SPIN_CAP) { atomicAdd(&bar[XB_TMO], 1u); break; } }
    }
    nloc = mine > 0u ? mine : 1u; nx = cnt > 0u ? cnt : 1u;
}

__device__ __forceinline__ void xcd_barrier(const XcdBarrier& b) {
    asm volatile("s_waitcnt vmcnt(0)" ::: "memory");
    __syncthreads();
    if (threadIdx.x == 0) {
        unsigned* bar = b.bar;
        __builtin_amdgcn_s_waitcnt(0);
        unsigned nloc = b.st[0], nx = b.st[1];
        if (nloc == 0u) { xcd_barrier_complete(bar, b.x, nloc, nx); b.st[0] = nloc; b.st[1] = nx; }
        const unsigned old = xb_add(&bar[XB_XSUB(b.x)], 1u);
        const unsigned gen = old / nloc;
        if (old + 1u == (gen + 1u) * nloc) {
            __builtin_amdgcn_fence(__ATOMIC_RELEASE, "agent");
            asm volatile("s_waitcnt vmcnt(0)" ::: "memory");
            const unsigned og = xb_add(&bar[XB_TOP], 1u);
            const unsigned tg = og / nx;
            if (og + 1u == (tg + 1u) * nx) xb_add(&bar[XB_TOPGEN], 1u);
            else XB_SPIN(xb_ld(&bar[XB_TOPGEN]) == tg, bar);
            __builtin_amdgcn_fence(__ATOMIC_ACQUIRE, "agent");
            xb_add(&bar[XB_XGEN(b.x)], 1u);
            asm volatile("s_waitcnt vmcnt(0)" ::: "memory");
        } else {
            XB_SPIN(xb_ld(&bar[XB_XGEN(b.x)]) == gen, bar);
            __builtin_amdgcn_fence(__ATOMIC_ACQUIRE, "agent");
            asm volatile("s_waitcnt vmcnt(0)" ::: "memory");
        }
    }
    __syncthreads();
}

#ifndef MK_SKIP
#define MK_SKIP 0
#endif
#ifndef MK_REP
#define MK_REP 0
#endif
#ifndef MK_PROBE_ON
#define MK_PROBE_ON 0
#define MK_PROBE_A 0
#define MK_PROBE_B 9
#endif
__global__ void __launch_bounds__(512, 2) mk_fwd(Args args) {
    extern __shared__ __attribute__((aligned(16))) unsigned char lds_raw[];
    Frame F;
    F.lds = (LAS unsigned char*)lds_raw; F.ws = args.ws; F.in = args.in; F.out = args.out;
    F.tid = threadIdx.x; F.lane = F.tid & 63; F.wave = __builtin_amdgcn_readfirstlane(F.tid >> 6);
    F.G = gridDim.x; { const int bx = blockIdx.x; F.vcu = (F.G % 8 == 0) ? (bx % 8) * (F.G / 8) + bx / 8 : bx; }
    const int lo = args.ph_lo, hi = args.ph_hi;
    XcdBarrier bar; bar.bar = (unsigned*)(args.ws + WS_BAR); bar.x = 0; bar.st = nullptr;
    if (hi - lo > 1) {
        volatile LAS unsigned* st = (volatile LAS unsigned*)(F.lds + 131072 + 64);
        if (F.tid < 2) st[F.tid] = 0u;
        __syncthreads();
        bar = xcd_barrier_post((unsigned*)(args.ws + WS_BAR), st);
    }
#if MK_PROBE_ON
    unsigned long long ts_a = 0, ts_b = 0;
#define STAMP(k) do { if ((k) == MK_PROBE_A) ts_a = __builtin_amdgcn_s_memrealtime(); if ((k) == MK_PROBE_B) ts_b = __builtin_amdgcn_s_memrealtime(); } while (0)
#else
#define STAMP(k) do {} while (0)
#endif
#define IN(k) (lo <= (k) && (k) < hi)
#define SEAM(k) do { if (IN(k) && IN((k) + 1)) xcd_barrier(bar); } while (0)
    unsigned char* ws = args.ws;
    bf16* QKVU = (bf16*)(ws + WS_QKVU); bf16* GATE = (bf16*)(ws + WS_GATE);

    STAMP(0);
#if !((MK_SKIP >> 0) & 1)
#if (MK_REP & 64)
    for (int q = 0; q < 8; ++q) xcd_barrier(bar);
#endif
    if (IN(0)) { p0_prologue(F); __syncthreads(); }
#if (MK_REP & 1)
    xcd_barrier(bar); if (IN(0)) { p0_prologue(F); __syncthreads(); }
#endif
#endif
    SEAM(0);

    STAMP(1);
#if !((MK_SKIP >> 1) & 1)
    if (IN(1)) {
        p1_extras(F);
        pg8::Gemm g{(const bf16*)(ws + WS_RA), (const bf16*)(ws + WS_WIN), MROWS, 4096, 1024}; pg8::StaticOrder S; S.init(MROWS, 4096, F.G, (int)blockIdx.x);
        pg8::EpiProj E{QKVU, GATE};
        pg8::gemm_phase<pg8::EpiProj, pg8::StaticOrder, true, true>(F.lds, g, S, E);
    }
#endif
    SEAM(1);

    STAMP(2);
#if !((MK_SKIP >> 2) & 1)
    if (IN(2)) {
        meta_p2(F);
        for (int rep = 0; rep < 1 + ((MK_REP >> 2) & 1); ++rep)
        for (int u = F.vcu; u < 256; u += F.G) s5_unit(F, u & 31, u >> 5);
        for (int rep = 0; rep < 1 + ((MK_REP >> 3) & 1); ++rep)
        for (int pu = F.vcu; pu < 512; pu += F.G) { const int bh = pu >> 2, qp = pu & 3; attn_unit(F, bh >> 3, bh & 7, 7 - qp); attn_unit(F, bh >> 3, bh & 7, qp); }
    }
#endif
    SEAM(2);

    STAMP(3);
#if !((MK_SKIP >> 3) & 1)
    if (IN(3)) {
        meta_p3(F);
        { pg8::Gemm g{(const bf16*)(ws + WS_RB), (const bf16*)(ws + WS_WA), MROWS, 1024, 512}; pg8::PairOrder S{F.G, F.vcu, 2};
          pg8::EpiYa E{GATE, F.out};
          pg8::gemm_phase<pg8::EpiYa, pg8::PairOrder, true, true>(F.lds, g, S, E); }
        { pg8::Gemm g{(const bf16*)(ws + WS_RB + 32 * MiB), (const bf16*)(ws + WS_WG), MROWS, 2048, 512}; pg8::PairOrder S{F.G, F.vcu, 4};
          pg8::EpiGlu E{GATE, F.out, (bf16*)(ws + WS_RA)};
          pg8::gemm_phase<pg8::EpiGlu, pg8::PairOrder, true, true>(F.lds, g, S, E); }
    }
#endif
    SEAM(3);

    STAMP(4);
#if !((MK_SKIP >> 4) & 1)
    if (IN(4)) {
        meta_p4(F);
        pg8::Gemm g{(const bf16*)(ws + WS_RA), (const bf16*)(ws + WS_WO), MROWS, 1024, 1024}; pg8::StaticOrder S; S.init(MROWS, 1024, F.G, (int)blockIdx.x);
        pg8::EpiRes<true> E{F.in[0], F.out, (bf16*)(ws + WS_RB), (float*)(ws + WS_ROWSS1)};
        pg8::gemm_phase<pg8::EpiRes<true>, pg8::StaticOrder, true, true>(F.lds, g, S, E);
    }
#endif
    SEAM(4);

    STAMP(5);
#if !((MK_SKIP >> 5) & 1)
    if (IN(5)) {
        meta_p5(F);
        pg8::Gemm g{(const bf16*)(ws + WS_RB), (const bf16*)(ws + WS_WUP), MROWS, FF2, 1024}; pg8::StaticOrder S; S.init(MROWS, FF2, F.G, (int)blockIdx.x);
        pg8::EpiUp E{(const float*)(ws + WS_ROWSS1), (const float*)(ws + WS_CP), (bf16*)(ws + WS_ACT), (float*)(ws + WS_EDGE)};
        pg8::gemm_phase<pg8::EpiUp, pg8::StaticOrder, true, true>(F.lds, g, S, E);
    }
#endif
    SEAM(5);

    STAMP(6);
#if !((MK_SKIP >> 6) & 1)
    if (IN(6)) { p6_fixup(F); }
#endif
    SEAM(6);

    STAMP(7);
#if !((MK_SKIP >> 7) & 1)
    if (IN(7)) {
        pg8::Gemm g{(const bf16*)(ws + WS_ACT), (const bf16*)(ws + WS_WDN), MROWS, 1024, FF}; pg8::StaticOrder S; S.init(MROWS, 1024, F.G, (int)blockIdx.x);
        pg8::EpiRes<false> E{F.out, F.out, nullptr, (float*)(ws + WS_ROWSS2)};
        pg8::gemm_phase<pg8::EpiRes<false>, pg8::StaticOrder, true, true>(F.lds, g, S, E);
    }
#endif
    SEAM(7);

    STAMP(8);
#if !((MK_SKIP >> 8) & 1)
    if (IN(8)) { p8_final(F); }
#endif
    STAMP(9);
#if MK_PROBE_ON
    __syncthreads();
    if (blockIdx.x == 0 && F.tid == 0) F.out[0] += (float)(ts_b - ts_a) * 0.01f;
#endif
#undef IN
#undef SEAM
}

extern "C" void kernel_launch(void* const* d_in, const int* in_sizes, int n_in, void* d_out, int out_size, void* d_ws, size_t ws_size, hipStream_t stream) {
    static int grid = 0;
    if (grid == 0) {
        if (n_in != 22 || in_sizes[0] != MROWS * DM || out_size != MROWS * DM || ws_size < WS_END) { fprintf(stderr, "kernel_launch: unexpected shapes / workspace (n_in %d, ws %zu)\n", n_in, ws_size); grid = -1; return; }
        int dev = 0, cus = 0, per_cu = 0;
        if (hipGetDevice(&dev) != hipSuccess || hipDeviceGetAttribute(&cus, hipDeviceAttributeMultiprocessorCount, dev) != hipSuccess) { grid = -1; return; }
        if (hipFuncSetAttribute((const void*)mk_fwd, hipFuncAttributeMaxDynamicSharedMemorySize, LDS_BYTES) != hipSuccess) { fprintf(stderr, "kernel_launch: hipFuncSetAttribute failed\n"); grid = -1; return; }
        if (hipOccupancyMaxActiveBlocksPerMultiprocessor(&per_cu, (const void*)mk_fwd, 512, LDS_BYTES) != hipSuccess || per_cu < 1) { fprintf(stderr, "kernel_launch: occupancy query failed (%d)\n", per_cu); (void)hipGetLastError(); per_cu = 1; }
        grid = cus * per_cu;
        if (grid > 256) grid = 256;
    }
    if (grid < 0) return;
    Args a{};
    for (int i = 0; i < 22; ++i) a.in[i] = (const float*)d_in[i];
    a.out = (float*)d_out; a.ws = (unsigned char*)d_ws;
#if MK_PER_PHASE
    for (int p = 0; p < NPHASE; ++p) { a.ph_lo = p; a.ph_hi = p + 1; hipLaunchKernelGGL(mk_fwd, dim3(grid), dim3(512), LDS_BYTES, stream, a); }
#else
    a.ph_lo = 0; a.ph_hi = NPHASE;
    if (hipMemsetAsync((char*)d_ws + WS_BAR, 0, 16384, stream) != hipSuccess) { fprintf(stderr, "kernel_launch: memset of the barrier words failed\n"); return; }
    hipLaunchKernelGGL(mk_fwd, dim3(grid), dim3(512), LDS_BYTES, stream, a);
#endif
}
```

```cpp
#include <hip/hip_runtime.h>
#include <hip/hip_cooperative_groups.h>
#include <cstdio>
#include <cstdint>
namespace cg = cooperative_groups;

#ifndef MK_PER_PHASE
#define MK_PER_PHASE 0
#endif

constexpr int NB = 16, SEQ = 2048, NMETA = 16, DM = 1024, MROWS = NB * SEQ;
constexpr int NH = 8, DH = 64, AW = 512, SW = 512, NG = 32, NP = 64, FF = 2816, FF2 = 5632, INW = 4104;
constexpr int LTOT = SEQ + NMETA;
constexpr float RMS_EPS = 1e-6f;
constexpr float LOG2E = 1.4426950408889634f;
constexpr int NPHASE = 9;
namespace pg8 {
#define PG8_LAS __attribute__((address_space(3)))
typedef unsigned short bf16_t;
typedef short bf16x8 __attribute__((ext_vector_type(8)));
typedef float f32x4 __attribute__((ext_vector_type(4)));
typedef unsigned u32x4 __attribute__((ext_vector_type(4)));
constexpr int BM = 256, BK = 64, HALF = 128, HTB = HALF * BK * 2  , STAGE_BYTES = 8 * HTB, NXCD = 8, WGM = 8;

__host__ __device__ __forceinline__ int lds_byte(int r, int c) { const int st = (r >> 4) * 2 + (c >> 5), rr = r & 15, cc = c & 31, ob = rr * 64 + cc * 2; return st * 1024 + (ob ^ (((ob >> 9) & 1) << 5)); }
__host__ __device__ __forceinline__ void stage_rc(int b, int& R, int& C) { const int st = b / 1024, sb = b % 1024, swz = sb ^ (((sb >> 9) & 1) << 5); R = (st >> 1) * 16 + swz / 64; C = (st & 1) * 32 + (swz % 64) / 2; }
__host__ __device__ __forceinline__ int perm32(int rho) { const int n = rho >> 4, i = rho & 15; return 8 * (i >> 2) + 4 * n + (i & 3); }

struct Unit { int pm, pn; };
struct Gemm { const bf16_t* A; const bf16_t* Bt; int M, N, K; };

struct StaticOrder {
    int nM, nN, nwg, G, c;
    __host__ __device__ void init(int M, int N, int G_, int c_) { nM = M / BM; nN = N / BM; nwg = nM * nN; G = G_; c = c_; }
    __host__ __device__ bool next(int i, Unit& u) const {
        const long L = (long)i * G + c; if (L >= nwg) return false;
        int wgid = (int)L; { const int q = nwg / NXCD, r = nwg % NXCD, xcd = wgid % NXCD, off = wgid / NXCD; wgid = (xcd < r ? xcd * (q + 1) : r * (q + 1) + (xcd - r) * q) + off; }
        const int nig = WGM * nN, gid = wgid / nig, fm = gid * WGM, gsz = (nM - fm) < WGM ? (nM - fm) : WGM;
        u.pm = fm + ((wgid % nig) % gsz); u.pn = (wgid % nig) / gsz; return true;
    }
    __device__ __forceinline__ void a_ready(const Unit&) const {}
    __device__ __forceinline__ void done(const Unit&) const {}
};

__device__ __forceinline__ unsigned cvt_pk_bf16(float lo, float hi) { unsigned r; asm volatile("v_cvt_pk_bf16_f32 %0, %1, %2" : "=v"(r) : "v"(lo), "v"(hi)); return r; }
typedef float f32x2 __attribute__((ext_vector_type(2)));
typedef unsigned u32x4e __attribute__((ext_vector_type(4)));
typedef unsigned u32x2e __attribute__((ext_vector_type(2)));
__device__ __forceinline__ float fsig(float x) { return __builtin_amdgcn_rcpf(1.0f + __builtin_amdgcn_exp2f(-1.4426950408889634f * x)); }
__device__ __forceinline__ float bf_lo(unsigned w) { return __uint_as_float(w << 16); }
__device__ __forceinline__ float bf_hi(unsigned w) { return __uint_as_float(w & 0xffff0000u); }

struct EpiProj {
    static constexpr bool PERM = true, AFTER_DRAIN = false;
    bf16_t* QKVU; bf16_t* GATE;
    __device__ __forceinline__ void operator()(const f32x4 (&acc)[2][2][4][2], const Unit& u, int wr, int wc, int fr, int fq) const {
        const int row0 = u.pm * BM + wr * 64 + fr;
        const bool isg = u.pn >= 8;
        bf16_t* base; int ldc, colt;
        if (!isg) { base = QKVU + (size_t)(u.pn >> 1) * ((size_t)32768 * 512); ldc = 512; colt = (u.pn & 1) * 256; }
        else { base = GATE; ldc = 2048; colt = (u.pn - 8) * 256; }
        const int col0 = colt + wc * 32 + 8 * fq;
#pragma unroll
        for (int ai = 0; ai < 2; ++ai)
#pragma unroll
            for (int m = 0; m < 4; ++m) { bf16_t* rowp = base + (size_t)(row0 + ai * HALF + m * 16) * ldc + col0;
#pragma unroll
                for (int bj = 0; bj < 2; ++bj) { f32x4 v0 = acc[ai][bj][m][0], v1 = acc[ai][bj][m][1];
                    if (isg) { v0 = (f32x4){fsig(v0[0]), fsig(v0[1]), fsig(v0[2]), fsig(v0[3])}; v1 = (f32x4){fsig(v1[0]), fsig(v1[1]), fsig(v1[2]), fsig(v1[3])}; }
                    u32x4e w; w.x = cvt_pk_bf16(v0[0], v0[1]); w.y = cvt_pk_bf16(v0[2], v0[3]); w.z = cvt_pk_bf16(v1[0], v1[1]); w.w = cvt_pk_bf16(v1[2], v1[3]);
                    *(u32x4e*)(rowp + bj * HALF) = w; } }
    }
};

struct EpiYa {
    static constexpr bool PERM = true, AFTER_DRAIN = false;
    const bf16_t* GATE; bf16_t* PART;
    __device__ __forceinline__ void operator()(const f32x4 (&acc)[2][2][4][2], const Unit& u, int wr, int wc, int fr, int fq) const {
        const int row0 = u.pm * BM + wr * 64 + fr, col0 = u.pn * BM + wc * 32 + 8 * fq;
#pragma unroll
        for (int ai = 0; ai < 2; ++ai)
#pragma unroll
            for (int m = 0; m < 4; ++m) { const size_t row = (size_t)(row0 + ai * HALF + m * 16);
#pragma unroll
                for (int bj = 0; bj < 2; ++bj) { const int col = col0 + bj * HALF;
                    const u32x4e g = *(const u32x4e*)(GATE + row * 2048 + col);
                    f32x4 v0 = acc[ai][bj][m][0], v1 = acc[ai][bj][m][1];
                    v0 = v0 * (f32x4){bf_lo(g.x), bf_hi(g.x), bf_lo(g.y), bf_hi(g.y)}; v1 = v1 * (f32x4){bf_lo(g.z), bf_hi(g.z), bf_lo(g.w), bf_hi(g.w)};
                    u32x4e w; w.x = cvt_pk_bf16(v0[0], v0[1]); w.y = cvt_pk_bf16(v0[2], v0[3]); w.z = cvt_pk_bf16(v1[0], v1[1]); w.w = cvt_pk_bf16(v1[2], v1[3]);
                    *(u32x4e*)(PART + row * 1024 + col) = w; } }
    }
};

struct EpiGlu {
    static constexpr bool PERM = true, AFTER_DRAIN = false;
    const bf16_t* GATE; const bf16_t* PART; bf16_t* MERGED;
    __device__ __forceinline__ void operator()(const f32x4 (&acc)[2][2][4][2], const Unit& u, int wr, int wc, int fr, int fq) const {
        const int row0 = u.pm * BM + wr * 64 + fr, col = u.pn * HALF + wc * 32 + 8 * fq;
#pragma unroll
        for (int ai = 0; ai < 2; ++ai)
#pragma unroll
            for (int m = 0; m < 4; ++m) { const size_t row = (size_t)(row0 + ai * HALF + m * 16);
                const u32x4e g = *(const u32x4e*)(GATE + row * 2048 + 1024 + col);
                const u32x4e pw = *(const u32x4e*)(PART + row * 1024 + col); const f32x4 p0 = (f32x4){bf_lo(pw.x), bf_hi(pw.x), bf_lo(pw.y), bf_hi(pw.y)}, p1 = (f32x4){bf_lo(pw.z), bf_hi(pw.z), bf_lo(pw.w), bf_hi(pw.w)};
                const f32x4 a0 = acc[ai][0][m][0], a1 = acc[ai][0][m][1], b0 = acc[ai][1][m][0], b1 = acc[ai][1][m][1];
                f32x4 y0 = (f32x4){a0[0] * fsig(b0[0]), a0[1] * fsig(b0[1]), a0[2] * fsig(b0[2]), a0[3] * fsig(b0[3])};
                f32x4 y1 = (f32x4){a1[0] * fsig(b1[0]), a1[1] * fsig(b1[1]), a1[2] * fsig(b1[2]), a1[3] * fsig(b1[3])};
                y0 = p0 + y0 * (f32x4){bf_lo(g.x), bf_hi(g.x), bf_lo(g.y), bf_hi(g.y)}; y1 = p1 + y1 * (f32x4){bf_lo(g.z), bf_hi(g.z), bf_lo(g.w), bf_hi(g.w)};
                u32x4e w; w.x = cvt_pk_bf16(y0[0], y0[1]); w.y = cvt_pk_bf16(y0[2], y0[3]); w.z = cvt_pk_bf16(y1[0], y1[1]); w.w = cvt_pk_bf16(y1[2], y1[3]);
                *(u32x4e*)(MERGED + row * 1024 + col) = w; }
    }
};

template <bool WITH_BF> struct EpiRes {
    static constexpr bool PERM = true, AFTER_DRAIN = false;
    const float* base; float* out; bf16_t* OB; float* rowss;
    __device__ __forceinline__ void operator()(const f32x4 (&acc)[2][2][4][2], const Unit& u, int wr, int wc, int fr, int fq) const {
        const int row0 = u.pm * BM + wr * 64 + fr, col0 = u.pn * BM + wc * 32 + 8 * fq;
#pragma unroll
        for (int ai = 0; ai < 2; ++ai)
#pragma unroll
            for (int m = 0; m < 4; ++m) { const size_t row = (size_t)(row0 + ai * HALF + m * 16); float ss = 0.f;
#pragma unroll
                for (int bj = 0; bj < 2; ++bj) { const size_t off = row * 1024 + col0 + bj * HALF;
                    const f32x4 r0 = *(const f32x4*)(base + off), r1 = *(const f32x4*)(base + off + 4);
                    const f32x4 v0 = acc[ai][bj][m][0] + r0, v1 = acc[ai][bj][m][1] + r1;
                    *(f32x4*)(out + off) = v0; *(f32x4*)(out + off + 4) = v1;
                    ss += (v0[0] * v0[0] + v0[1] * v0[1]) + (v0[2] * v0[2] + v0[3] * v0[3]) + (v1[0] * v1[0] + v1[1] * v1[1]) + (v1[2] * v1[2] + v1[3] * v1[3]);
                    if (WITH_BF) { u32x4e w; w.x = cvt_pk_bf16(v0[0], v0[1]); w.y = cvt_pk_bf16(v0[2], v0[3]); w.z = cvt_pk_bf16(v1[0], v1[1]); w.w = cvt_pk_bf16(v1[2], v1[3]);
                        *(u32x4e*)(OB + off) = w; } }
                ss += __shfl_xor(ss, 16); ss += __shfl_xor(ss, 32);
                if (fq == 0) atomicAdd(rowss + row, ss); }
    }
};

struct EpiWo {
    static constexpr bool PERM = true, AFTER_DRAIN = false;
    const float* base; bf16_t* OB; float* rowss;
    __device__ __forceinline__ void operator()(const f32x4 (&acc)[2][2][4][2], const Unit& u, int wr, int wc, int fr, int fq) const {
        const int row0 = u.pm * BM + wr * 64 + fr, col0 = u.pn * BM + wc * 32 + 8 * fq;
#pragma unroll
        for (int ai = 0; ai < 2; ++ai)
#pragma unroll
            for (int m = 0; m < 4; ++m) { const size_t row = (size_t)(row0 + ai * HALF + m * 16); float ss = 0.f;
#pragma unroll
                for (int bj = 0; bj < 2; ++bj) { const size_t off = row * 1024 + col0 + bj * HALF;
                    const f32x4 r0 = *(const f32x4*)(base + off), r1 = *(const f32x4*)(base + off + 4);
                    const f32x4 v0 = acc[ai][bj][m][0] + r0, v1 = acc[ai][bj][m][1] + r1;
                    ss += (v0[0] * v0[0] + v0[1] * v0[1]) + (v0[2] * v0[2] + v0[3] * v0[3]) + (v1[0] * v1[0] + v1[1] * v1[1]) + (v1[2] * v1[2] + v1[3] * v1[3]);
                    u32x4e w; w.x = cvt_pk_bf16(v0[0], v0[1]); w.y = cvt_pk_bf16(v0[2], v0[3]); w.z = cvt_pk_bf16(v1[0], v1[1]); w.w = cvt_pk_bf16(v1[2], v1[3]);
                    *(u32x4e*)(OB + off) = w; }
                ss += __shfl_xor(ss, 16); ss += __shfl_xor(ss, 32);
                if (fq == 0) atomicAdd(rowss + row, ss); }
    }
};
struct EpiDown {
    static constexpr bool PERM = true, AFTER_DRAIN = false;
    const bf16_t* base; bf16_t* OB; float* rowss;
    __device__ __forceinline__ void operator()(const f32x4 (&acc)[2][2][4][2], const Unit& u, int wr, int wc, int fr, int fq) const {
        const int row0 = u.pm * BM + wr * 64 + fr, col0 = u.pn * BM + wc * 32 + 8 * fq;
#pragma unroll
        for (int ai = 0; ai < 2; ++ai)
#pragma unroll
            for (int m = 0; m < 4; ++m) { const size_t row = (size_t)(row0 + ai * HALF + m * 16); float ss = 0.f;
#pragma unroll
                for (int bj = 0; bj < 2; ++bj) { const size_t off = row * 1024 + col0 + bj * HALF;
                    const u32x4e b = *(const u32x4e*)(base + off);
                    const f32x4 v0 = acc[ai][bj][m][0] + (f32x4){bf_lo(b.x), bf_hi(b.x), bf_lo(b.y), bf_hi(b.y)}, v1 = acc[ai][bj][m][1] + (f32x4){bf_lo(b.z), bf_hi(b.z), bf_lo(b.w), bf_hi(b.w)};
                    ss += (v0[0] * v0[0] + v0[1] * v0[1]) + (v0[2] * v0[2] + v0[3] * v0[3]) + (v1[0] * v1[0] + v1[1] * v1[1]) + (v1[2] * v1[2] + v1[3] * v1[3]);
                    u32x4e w; w.x = cvt_pk_bf16(v0[0], v0[1]); w.y = cvt_pk_bf16(v0[2], v0[3]); w.z = cvt_pk_bf16(v1[0], v1[1]); w.w = cvt_pk_bf16(v1[2], v1[3]);
                    *(u32x4e*)(OB + off) = w; }
                ss += __shfl_xor(ss, 16); ss += __shfl_xor(ss, 32);
                if (fq == 0) atomicAdd(rowss + row, ss); }
    }
};

struct EpiUp {
    static constexpr bool PERM = true, AFTER_DRAIN = false;
    const float* rowss; const float* CP; bf16_t* ACT; float* EDGE;
    __device__ __forceinline__ void operator()(const f32x4 (&acc)[2][2][4][2], const Unit& u, int wr, int wc, int fr, int fq) const {
        const int lane = fq * 16 + fr;
        const int ch0 = u.pn * HALF + wc * 32 + 8 * fq;
        const int idx1 = ((lane & ~15) | ((fr - 1) & 15)) << 2, idx2 = ((lane & ~15) | ((fr - 2) & 15)) << 2;
        const bool s15 = fr == 15, s14 = fr >= 14;
        const bool edge = fr < 2 || fr >= 14; const int slot = fr < 2 ? fr : fr - 12;
        const unsigned cpo = (unsigned)ch0 * 32u;
#pragma unroll
        for (int ai = 0; ai < 2; ++ai) {
            const int rowb = u.pm * BM + ai * HALF + wr * 64;
            const unsigned rso = (unsigned)(rowb + fr) * 4u;
            float rs[4];
#pragma unroll
            for (int m = 0; m < 4; ++m) rs[m] = rsqrtf(*(const float*)((const char*)rowss + rso + m * 64) * (1.0f / 1024.0f) + 1e-6f);
            const unsigned ebo = (((unsigned)(rowb >> 6) * 8u + (unsigned)slot * 2u) * 2816u + (unsigned)ch0) * 4u;
            const unsigned aco = ((unsigned)(rowb + fr) * 2816u + (unsigned)ch0) * 2u;
#pragma unroll
            for (int n = 0; n < 2; ++n) {
                float ov[4][4];
#pragma unroll
                for (int e = 0; e < 4; ++e) {
                    const f32x4 wv = *(const f32x4*)((const char*)CP + cpo + (4 * n + e) * 32), wg = *(const f32x4*)((const char*)CP + cpo + (4 * n + e) * 32 + 16);
                    float hv[4], hg[4];
#pragma unroll
                    for (int m = 0; m < 4; ++m) { hv[m] = acc[ai][0][m][n][e] * rs[m]; hg[m] = acc[ai][1][m][n][e] * rs[m]; }
                    if (edge) { *(float*)((char*)EDGE + ebo + (4 * n + e) * 4) = fr < 2 ? hv[0] : hv[3]; *(float*)((char*)EDGE + ebo + 2816 * 4 + (4 * n + e) * 4) = fr < 2 ? hg[0] : hg[3]; }
#pragma unroll
                    for (int m = 0; m < 4; ++m) {
                        const float pv = m > 0 ? hv[m - 1] : 0.f, pg = m > 0 ? hg[m - 1] : 0.f;
                        const float v1 = __int_as_float(__builtin_amdgcn_ds_bpermute(idx1, __float_as_int(s15 ? pv : hv[m])));
                        const float v2 = __int_as_float(__builtin_amdgcn_ds_bpermute(idx2, __float_as_int(s14 ? pv : hv[m])));
                        const float g1 = __int_as_float(__builtin_amdgcn_ds_bpermute(idx1, __float_as_int(s15 ? pg : hg[m])));
                        const float g2 = __int_as_float(__builtin_amdgcn_ds_bpermute(idx2, __float_as_int(s14 ? pg : hg[m])));
                        const float o1 = wv[3] + wv[0] * v2 + wv[1] * v1 + wv[2] * hv[m];
                        const float og = wg[3] + wg[0] * g2 + wg[1] * g1 + wg[2] * hg[m];
                        ov[m][e] = og * fsig(og) * o1;
                    }
                }
#pragma unroll
                for (int m = 0; m < 4; ++m) { u32x2e w; w.x = cvt_pk_bf16(ov[m][0], ov[m][1]); w.y = cvt_pk_bf16(ov[m][2], ov[m][3]);
                    *(u32x2e*)((char*)ACT + aco + (unsigned)(m * 16 * 2816 * 2) + n * 8) = w; }
                asm volatile("" ::: "memory");
            }
        }
    }
};

struct PairOrder {
    int G, c, per;
    __device__ bool next(int i, Unit& u) const { const int su = (i / per) * G + c; if (su >= 256) return false; u.pm = su >> 1; u.pn = (su & 1) * per + (i % per); return true; }
    __device__ __forceinline__ void a_ready(const Unit&) const {}
    __device__ __forceinline__ void done(const Unit&) const {}
};

template <class Epi, class Sched, bool ALIGN_EPI = false, bool SP2 = false>
__device__ __forceinline__ void gemm_phase(PG8_LAS unsigned char* lds, const Gemm g, const Sched& S, const Epi& E) {
    const int tid = threadIdx.x, wid = __builtin_amdgcn_readfirstlane(tid >> 6), lane = tid & 63, wr = wid >> 2, wc = wid & 3, fr = lane & 15, fq = lane >> 4;
    const int K = g.K, nt = K / BK;
    unsigned voffA[2], voffB[2];
#pragma unroll
    for (int i = 0; i < 2; ++i) { int R, C; stage_rc(tid * 16 + i * 8192, R, C); const int Rb = Epi::PERM ? ((R & ~31) + perm32(R & 31)) : R;
        voffA[i] = (unsigned)(R * K + C) * 2u; voffB[i] = (unsigned)(Rb * K + C) * 2u; }
    const size_t kstep = (size_t)(BK * 2);
    const size_t hstep = (size_t)HALF * K * 2;
    const size_t tstep = 2 * hstep;
    const unsigned ldsw = (unsigned)wid * 1024u;
    const int aoff = lds_byte(wr * 64 + fr, fq * 8), boff = lds_byte(wc * 32 + fr, fq * 8);
#define PG8_SA(b, h) (((b) * 2 + (h)) * HTB)
#define PG8_SB(b, h) ((4 + (b) * 2 + (h)) * HTB)
#define PG8_STAGE(bufoff, gbase, voff) do { _Pragma("unroll") for (int _i = 0; _i < 2; ++_i) \
        __builtin_amdgcn_global_load_lds((const unsigned*)((const char*)(gbase) + (voff)[_i]), (PG8_LAS unsigned*)(lds + (bufoff) + ldsw + _i * 8192), 16, 0, 0); } while (0)
#define PG8_LDA(dst, b, h) do { _Pragma("unroll") for (int m = 0; m < 4; ++m) _Pragma("unroll") for (int k = 0; k < 2; ++k) dst[m][k] = *(const PG8_LAS bf16x8*)(lds + PG8_SA(b, h) + aoff + m * 2048 + k * 1024); } while (0)
#define PG8_LDB(dst, b, h) do { _Pragma("unroll") for (int n = 0; n < 2; ++n) _Pragma("unroll") for (int k = 0; k < 2; ++k) dst[n][k] = *(const PG8_LAS bf16x8*)(lds + PG8_SB(b, h) + boff + n * 2048 + k * 1024); } while (0)
#define PG8_MMA(ai, bj, At, Bt) do { __builtin_amdgcn_s_setprio(1); _Pragma("unroll") for (int m = 0; m < 4; ++m) _Pragma("unroll") for (int n = 0; n < 2; ++n) _Pragma("unroll") for (int k = 0; k < 2; ++k) \
        acc[ai][bj][m][n] = __builtin_amdgcn_mfma_f32_16x16x32_bf16(Bt[n][k], At[m][k], acc[ai][bj][m][n], 0, 0, 0); __builtin_amdgcn_s_setprio(0); } while (0)
#define PG8_WAIT_V(n) asm volatile("s_waitcnt vmcnt(" #n ")" ::: "memory")
#define PG8_WAIT_L(n) asm volatile("s_waitcnt lgkmcnt(" #n ")" ::: "memory")
#define PG8_BAR __builtin_amdgcn_s_barrier()
#define PG8_SCHED __builtin_amdgcn_sched_barrier(0)
    Unit cur, nxt; int ui = 0;
    if (!S.next(0, cur)) return;
    f32x4 acc[2][2][4][2];
#pragma unroll
    for (int a = 0; a < 2; ++a)
#pragma unroll
        for (int b = 0; b < 2; ++b)
#pragma unroll
            for (int m = 0; m < 4; ++m)
#pragma unroll
                for (int n = 0; n < 2; ++n) acc[a][b][m][n] = (f32x4){0.f, 0.f, 0.f, 0.f};
    bf16x8 At[4][2], B0[2][2], B1[2][2];
    const char* cA = (const char*)g.A + (size_t)cur.pm * tstep; const char* cB = (const char*)g.Bt + (size_t)cur.pn * tstep;
    S.a_ready(cur);
    if constexpr (SP2) {
        PG8_STAGE(PG8_SB(0, 0), cB, voffB); PG8_STAGE(PG8_SB(0, 1), cB + hstep, voffB); PG8_STAGE(PG8_SA(0, 0), cA, voffA); PG8_STAGE(PG8_SA(0, 1), cA + hstep, voffA);
        if (wr == 1) PG8_BAR;
        PG8_WAIT_V(2); PG8_BAR;
        PG8_STAGE(PG8_SB(1, 0), cB + kstep, voffB); PG8_STAGE(PG8_SA(1, 0), cA + kstep, voffA); PG8_STAGE(PG8_SB(1, 1), cB + hstep + kstep, voffB);
        PG8_WAIT_V(6); PG8_BAR;
    } else {
        PG8_STAGE(PG8_SB(0, 0), cB, voffB); PG8_STAGE(PG8_SA(0, 0), cA, voffA); PG8_STAGE(PG8_SB(0, 1), cB + hstep, voffB); PG8_STAGE(PG8_SA(0, 1), cA + hstep, voffA);
        if (wr == 1) PG8_BAR;
        PG8_WAIT_V(4); PG8_BAR;
        PG8_STAGE(PG8_SB(1, 0), cB + kstep, voffB); PG8_STAGE(PG8_SA(1, 0), cA + kstep, voffA); PG8_STAGE(PG8_SB(1, 1), cB + hstep + kstep, voffB);
        PG8_WAIT_V(6); PG8_BAR;
    }
    for (;;) {
        const bool has_next = S.next(ui + 1, nxt);
        const char* nA = has_next ? (const char*)g.A + (size_t)nxt.pm * tstep : cA; const char* nB = has_next ? (const char*)g.Bt + (size_t)nxt.pn * tstep : cB;
        for (int t = 0; t < nt; t += 2) {
            const bool last = (t == nt - 2);
            const char* a1 = cA + (size_t)(t + 1) * kstep;
            const char* a2 = last ? nA : cA + (size_t)(t + 2) * kstep; const char* b2 = last ? nB : cB + (size_t)(t + 2) * kstep;
            const char* a3 = a2 + kstep; const char* b3 = b2 + kstep;
            if (last && has_next) S.a_ready(nxt);
            if constexpr (SP2) {
            PG8_LDB(B0, 0, 0); PG8_LDB(B1, 0, 1); PG8_SCHED; PG8_LDA(At, 0, 0); PG8_STAGE(PG8_SA(1, 1), a1 + hstep, voffA);
            PG8_WAIT_V(8); PG8_WAIT_L(0); PG8_BAR; PG8_MMA(0, 0, At, B0); PG8_MMA(0, 1, At, B1); PG8_BAR; PG8_SCHED;
            PG8_LDA(At, 0, 1); PG8_STAGE(PG8_SB(0, 0), b2, voffB); PG8_STAGE(PG8_SB(0, 1), b2 + hstep, voffB); PG8_STAGE(PG8_SA(0, 0), a2, voffA);
            PG8_WAIT_V(8); PG8_WAIT_L(0); PG8_BAR; PG8_MMA(1, 0, At, B0); PG8_MMA(1, 1, At, B1); PG8_BAR; PG8_SCHED;
            PG8_LDB(B0, 1, 0); PG8_LDB(B1, 1, 1); PG8_SCHED; PG8_LDA(At, 1, 0); PG8_STAGE(PG8_SA(0, 1), a2 + hstep, voffA);
            PG8_WAIT_V(8); PG8_WAIT_L(0); PG8_BAR; PG8_MMA(0, 0, At, B0); PG8_MMA(0, 1, At, B1); PG8_BAR; PG8_SCHED;
            PG8_LDA(At, 1, 1); PG8_STAGE(PG8_SB(1, 0), b3, voffB); PG8_STAGE(PG8_SB(1, 1), b3 + hstep, voffB); PG8_STAGE(PG8_SA(1, 0), a3, voffA);
            PG8_WAIT_V(8); PG8_WAIT_L(0); PG8_BAR; PG8_MMA(1, 0, At, B0); PG8_MMA(1, 1, At, B1); PG8_BAR; PG8_SCHED;
            } else {
            PG8_LDB(B0, 0, 0); PG8_SCHED; PG8_LDA(At, 0, 0); PG8_STAGE(PG8_SA(1, 1), a1 + hstep, voffA);
            PG8_WAIT_L(8); PG8_BAR; PG8_WAIT_L(0); PG8_MMA(0, 0, At, B0); PG8_BAR; PG8_SCHED;
            PG8_LDB(B1, 0, 1); PG8_STAGE(PG8_SB(0, 0), b2, voffB);
            PG8_BAR; PG8_WAIT_L(0); PG8_MMA(0, 1, At, B1); PG8_BAR;
            PG8_LDA(At, 0, 1); PG8_STAGE(PG8_SA(0, 0), a2, voffA);
            PG8_BAR; PG8_WAIT_L(0); PG8_MMA(1, 0, At, B0); PG8_BAR; PG8_SCHED;
            PG8_STAGE(PG8_SB(0, 1), b2 + hstep, voffB);
            PG8_WAIT_V(6); PG8_BAR; PG8_MMA(1, 1, At, B1); PG8_BAR;
            PG8_LDB(B0, 1, 0); PG8_SCHED; PG8_LDA(At, 1, 0); PG8_STAGE(PG8_SA(0, 1), a2 + hstep, voffA);
            PG8_WAIT_L(8); PG8_BAR; PG8_WAIT_L(0); PG8_MMA(0, 0, At, B0); PG8_BAR; PG8_SCHED;
            PG8_LDB(B1, 1, 1); PG8_STAGE(PG8_SB(1, 0), b3, voffB);
            PG8_BAR; PG8_WAIT_L(0); PG8_MMA(0, 1, At, B1); PG8_BAR;
            PG8_LDA(At, 1, 1); PG8_STAGE(PG8_SA(1, 0), a3, voffA);
            PG8_BAR; PG8_WAIT_L(0); PG8_MMA(1, 0, At, B0); PG8_BAR; PG8_SCHED;
            PG8_STAGE(PG8_SB(1, 1), b3 + hstep, voffB);
            PG8_WAIT_V(6); PG8_BAR; PG8_MMA(1, 1, At, B1); PG8_BAR;
            }
        }
        if constexpr (ALIGN_EPI) { if (wr == 0) PG8_BAR; }
        if constexpr (!Epi::AFTER_DRAIN) { E(acc, cur, wr, wc, fr, fq); S.done(cur); }
        if (!has_next) break;
#pragma unroll
        for (int a = 0; a < 2; ++a)
#pragma unroll
            for (int b = 0; b < 2; ++b)
#pragma unroll
                for (int m = 0; m < 4; ++m)
#pragma unroll
                    for (int n = 0; n < 2; ++n) acc[a][b][m][n] = (f32x4){0.f, 0.f, 0.f, 0.f};
        cur = nxt; cA = nA; cB = nB; ++ui;
        if constexpr (ALIGN_EPI) { if (wr == 1) PG8_BAR; }
    }
    PG8_WAIT_V(0);
    if constexpr (!ALIGN_EPI) { if (wr == 0) PG8_BAR; }
    PG8_BAR;
    if constexpr (Epi::AFTER_DRAIN) { E.fused(acc, cur, wr, wc, fr, fq, lds, wid, lane); S.done(cur); }
#undef PG8_SA
#undef PG8_SB
#undef PG8_STAGE
#undef PG8_LDA
#undef PG8_LDB
#undef PG8_MMA
#undef PG8_WAIT_V
#undef PG8_WAIT_L
#undef PG8_BAR
#undef PG8_SCHED
}
}

#define LAS __attribute__((address_space(3)))
typedef unsigned short bf16;
typedef short bf16x8 __attribute__((ext_vector_type(8)));
typedef float f32x4 __attribute__((ext_vector_type(4)));
typedef float f32x16 __attribute__((ext_vector_type(16)));
typedef unsigned v4u __attribute__((ext_vector_type(4)));
typedef unsigned v2u __attribute__((ext_vector_type(2)));
typedef float f32x2v __attribute__((ext_vector_type(2)));
typedef __bf16 bf16x2n __attribute__((ext_vector_type(2)));
#define LDS_WAIT() asm volatile("s_waitcnt lgkmcnt(0)" ::: "memory")
__device__ __forceinline__ unsigned pk2(float lo, float hi) { f32x2v v = {lo, hi}; return __builtin_bit_cast(unsigned, __builtin_convertvector(v, bf16x2n)); }
__device__ __forceinline__ float bf2f(bf16 h) { return __uint_as_float((unsigned)h << 16); }
__device__ __forceinline__ float blo(unsigned w) { return __uint_as_float(w << 16); }
__device__ __forceinline__ float bhi(unsigned w) { return __uint_as_float(w & 0xffff0000u); }
__device__ __forceinline__ float fsigm(float x) { return __builtin_amdgcn_rcpf(1.0f + __builtin_amdgcn_exp2f(-LOG2E * x)); }
__device__ __forceinline__ float wave_sum(float v) {
#pragma unroll
    for (int o = 1; o < 64; o <<= 1) v += __shfl_xor(v, o);
    return v;
}

constexpr size_t MiB = 1u << 20;
constexpr size_t WS_ROWSS1 = 0, WS_ROWSS2 = 128 * 1024;
constexpr size_t WS_LOGFM = 256 * 1024;
constexpr size_t WS_BAR = 512 * 1024;
constexpr size_t WS_XNM = 1 * MiB;
constexpr size_t WS_QKVUM = WS_XNM + 64 * 1024;
constexpr size_t WS_GATEM = WS_QKVUM + 64 * 1024;
constexpr size_t WS_AA = WS_GATEM + 64 * 1024, WS_ZA = WS_AA + 16 * 1024;
constexpr size_t WS_MA = WS_ZA + 16 * 1024, WS_HA = WS_MA + 32 * 1024;
constexpr size_t WS_EDGEM = WS_HA + 32 * 1024;
constexpr size_t WS_CP = WS_EDGEM + 64 * 1024;
constexpr size_t WS_CPT = WS_CP + 128 * 1024;
constexpr size_t WS_LOGF = 2 * MiB;
constexpr size_t WS_CUMF = 3 * MiB;
constexpr size_t WS_WIN = 6 * MiB, WS_WA = 14 * MiB, WS_WG = 15 * MiB, WS_WO = 17 * MiB, WS_WUP = 19 * MiB, WS_WDN = 30 * MiB;
constexpr size_t WS_RA = 36 * MiB;
constexpr size_t WS_RB = 100 * MiB;
constexpr size_t WS_QKVU = 164 * MiB;
constexpr size_t WS_GATE = 292 * MiB;
constexpr size_t WS_ACT = 164 * MiB;
constexpr size_t WS_EDGE = 420 * MiB;
constexpr size_t WS_END = 464 * MiB;
constexpr int LDS_BYTES = 135168;

struct Args { const float* in[22]; float* out; unsigned char* ws; int ph_lo, ph_hi; };

struct Frame {
    LAS unsigned char* lds; unsigned char* ws; const float* const* in; float* out;
    int tid, lane, wave, vcu, G;
};

__device__ __forceinline__ void tr_item(const float* W, int K, int Nsrc, bf16* WT, int src_col0, int dst_row0, int k0, const float* gk, LAS float* scr, int lane) {
#pragma unroll
    for (int i = 0; i < 32; ++i) { const int kk = 2 * i + (lane >> 5); float v = W[(size_t)(k0 + kk) * Nsrc + src_col0 + (lane & 31)]; if (gk) v *= gk[k0 + kk]; scr[kk * 33 + (lane & 31)] = v; }
    LDS_WAIT(); asm volatile("" ::: "memory");
    const int c = lane & 7;
#pragma unroll
    for (int j = 0; j < 4; ++j) { const int n = (lane >> 3) + 8 * j; const LAS float* s = scr + (8 * c) * 33 + n;
        v4u o; o.x = pk2(s[0 * 33], s[1 * 33]); o.y = pk2(s[2 * 33], s[3 * 33]); o.z = pk2(s[4 * 33], s[5 * 33]); o.w = pk2(s[6 * 33], s[7 * 33]);
        *(v4u*)(WT + (size_t)(dst_row0 + n) * K + k0 + 8 * c) = o; }
    LDS_WAIT(); asm volatile("" ::: "memory");
}
__device__ __forceinline__ float log_sigmoid(float x) { return x >= 0.f ? -log1pf(expf(-x)) : x - log1pf(expf(x)); }

__device__ __forceinline__ void norm_row(f32x4 (&v)[4], const f32x4 (&gv)[4], bf16* orow, const LAS float* wf, const float* bfg, float* lf, int lane) {
    float s = 0.f;
#pragma unroll
    for (int j = 0; j < 4; ++j) s += (v[j].x * v[j].x + v[j].y * v[j].y) + (v[j].z * v[j].z + v[j].w * v[j].w);
    const float rstd = rsqrtf(wave_sum(s) * (1.f / DM) + RMS_EPS);
    float fa[8];
#pragma unroll
    for (int q = 0; q < 8; ++q) fa[q] = 0.f;
    unsigned long long* o8 = (unsigned long long*)orow + lane;
#pragma unroll
    for (int j = 0; j < 4; ++j) { v[j] = v[j] * rstd * gv[j];
        o8[64 * j] = (unsigned long long)pk2(v[j].x, v[j].y) | ((unsigned long long)pk2(v[j].z, v[j].w) << 32);
#pragma unroll
        for (int e = 0; e < 4; ++e) { const LAS f32x4* wp = (const LAS f32x4*)(wf + (size_t)(256 * j + 4 * lane + e) * 8); const f32x4 w0 = wp[0], w1 = wp[1]; const float xv = v[j][e];
            fa[0] += xv * w0.x; fa[1] += xv * w0.y; fa[2] += xv * w0.z; fa[3] += xv * w0.w; fa[4] += xv * w1.x; fa[5] += xv * w1.y; fa[6] += xv * w1.z; fa[7] += xv * w1.w; } }
    const bool b5 = lane & 32, b4 = lane & 16, b3 = lane & 8;
    float k4[4], k2[2], k1;
#pragma unroll
    for (int i = 0; i < 4; ++i) { const float snd = b5 ? fa[i] : fa[4 + i], kp = b5 ? fa[4 + i] : fa[i]; k4[i] = kp + __shfl_xor(snd, 32); }
#pragma unroll
    for (int i = 0; i < 2; ++i) { const float snd = b4 ? k4[i] : k4[2 + i], kp = b4 ? k4[2 + i] : k4[i]; k2[i] = kp + __shfl_xor(snd, 16); }
    { const float snd = b3 ? k2[0] : k2[1], kp = b3 ? k2[1] : k2[0]; k1 = kp + __shfl_xor(snd, 8); }
    k1 += __shfl_xor(k1, 4); k1 += __shfl_xor(k1, 2); k1 += __shfl_xor(k1, 1);
    if ((lane & 7) == 0) { const int q = lane >> 3; lf[q] = log_sigmoid(k1 + bfg[q]); }
}

__device__ __forceinline__ void p0_prologue(Frame& F) {
    const int gw = F.vcu * 8 + F.wave, NGW = F.G * 8, lane = F.lane;
    const float* const* in = F.in;
    { float* z = (float*)(F.ws + WS_ROWSS1); for (int i = blockIdx.x * 512 + F.tid; i < 2 * 32768; i += F.G * 512) z[i] = 0.f; }
    { float* cp = (float*)(F.ws + WS_CP); for (int i = blockIdx.x * 512 + F.tid; i < FF * 8; i += F.G * 512) { const int c = i >> 3, k = i & 7, cc = c + (k >= 4 ? FF : 0), kk = k & 3; const float pv = kk < 3 ? in[18][kk * FF2 + cc] : in[19][cc]; cp[i] = pv; ((float*)(F.ws + WS_CPT))[k * FF + c] = pv; } }
    LAS float* wf = (LAS float*)(F.lds);
#pragma unroll 16
    for (int i = F.tid; i < 1024 * 8; i += 512) wf[i] = in[3][(size_t)(i >> 3) * INW + 1536 + (i & 7)];
    __syncthreads();
    LAS float* scr = (LAS float*)(F.lds + 32768 + F.wave * 9216);
    constexpr int I_IN = 16 * 128, I_A = 8 * 32, I_G = 8 * 64, I_O = 16 * 32, I_UP = 16 * 176, I_DN = 44 * 32;
    constexpr int NITEMS = I_IN + I_A + I_G + I_O + I_UP + I_DN;
    for (int it = gw; it < NITEMS; it += NGW) {
        int r = it;
        if (r < I_IN) { const int kb = r / 128, db = r % 128; tr_item(in[3], 1024, INW, (bf16*)(F.ws + WS_WIN), db < 48 ? 32 * db : 1544 + 32 * (db - 48), 32 * db, 64 * kb, nullptr, scr, lane); continue; } r -= I_IN;
        if (r < I_A) { const int kb = r / 32, db = r % 32; tr_item(in[5], 512, 1024, (bf16*)(F.ws + WS_WA), 32 * db, 32 * db, 64 * kb, nullptr, scr, lane); continue; } r -= I_A;
        if (r < I_G) { const int kb = r / 64, db = r % 64, pn = db >> 3, wi = db & 7; tr_item(in[14], 512, 2048, (bf16*)(F.ws + WS_WG), wi < 4 ? 128 * pn + 32 * wi : 1024 + 128 * pn + 32 * (wi - 4), 32 * db, 64 * kb, nullptr, scr, lane); continue; } r -= I_G;
        if (r < I_O) { const int kb = r / 32, db = r % 32; tr_item(in[15], 1024, 1024, (bf16*)(F.ws + WS_WO), 32 * db, 32 * db, 64 * kb, nullptr, scr, lane); continue; } r -= I_O;
        if (r < I_UP) { const int kb = r / 176, db = r % 176, pn = db >> 3, wi = db & 7; tr_item(in[17], 1024, FF2, (bf16*)(F.ws + WS_WUP), wi < 4 ? 128 * pn + 32 * wi : FF + 128 * pn + 32 * (wi - 4), 32 * db, 64 * kb, in[16], scr, lane); continue; } r -= I_UP;
        { const int kb = r / 32, db = r % 32; tr_item(in[20], FF, 1024, (bf16*)(F.ws + WS_WDN), 32 * db, 32 * db, 64 * kb, nullptr, scr, lane); }
    }
    f32x4 gv[4];
#pragma unroll
    for (int j = 0; j < 4; ++j) gv[j] = ((const f32x4*)in[2])[lane + 64 * j];
    bf16* XN = (bf16*)(F.ws + WS_RA); float* LOGF = (float*)(F.ws + WS_LOGF);
    {   constexpr int PD = 3;
        f32x4 vq[PD][4];
        auto rowptr = [&](int m) -> const f32x4* { return (const f32x4*)(m < MROWS ? in[0] + (size_t)m * DM : in[1] + (size_t)(m - MROWS) * DM) + lane; };
#pragma unroll
        for (int d = 0; d < PD; ++d) if (gw + d * NGW < MROWS + NMETA) { const f32x4* xr = rowptr(gw + d * NGW);
#pragma unroll
            for (int j = 0; j < 4; ++j) vq[d][j] = xr[64 * j]; }
        for (int m = gw; m < MROWS + NMETA; m += NGW) {
            f32x4 v[4];
#pragma unroll
            for (int j = 0; j < 4; ++j) v[j] = vq[0][j];
#pragma unroll
            for (int d = 0; d < PD - 1; ++d)
#pragma unroll
                for (int j = 0; j < 4; ++j) vq[d][j] = vq[d + 1][j];
            if (m + PD * NGW < MROWS + NMETA) { const f32x4* xr = rowptr(m + PD * NGW);
#pragma unroll
                for (int j = 0; j < 4; ++j) vq[PD - 1][j] = xr[64 * j]; }
            if (m < MROWS) norm_row(v, gv, XN + (size_t)m * DM, wf, in[4], LOGF + (size_t)m * 8, lane);
            else { const int r = m - MROWS; norm_row(v, gv, (bf16*)(F.ws + WS_XNM) + (size_t)r * DM, wf, in[4], (float*)(F.ws + WS_LOGFM) + r * 8, lane); }
        }
    }
}

__device__ __forceinline__ f32x4 skinny_tile(const bf16* A, const bf16* Bt, int K, int ct, int lane) {
    const bf16* ap = A + (size_t)(lane & 15) * K + 8 * (lane >> 4);
    const bf16* bp = Bt + (size_t)(16 * ct + (lane & 15)) * K + 8 * (lane >> 4);
    f32x4 acc = {0.f, 0.f, 0.f, 0.f};
    for (int s = 0; s < K / 32; s += 16) {
        bf16x8 a[16], b[16];
#pragma unroll
        for (int q = 0; q < 16; ++q) { a[q] = *(const bf16x8*)(ap + 32 * (s + q)); b[q] = *(const bf16x8*)(bp + 32 * (s + q)); }
#pragma unroll
        for (int q = 0; q < 16; ++q) acc = __builtin_amdgcn_mfma_f32_16x16x32_bf16(a[q], b[q], acc, 0, 0, 0);
    }
    return acc;
}
template <int MODE>
__device__ __forceinline__ f32x4 skinny2(const void* X0, const void* X1, const bf16* Bt, int K, int ct, int lane) {
    const int row = lane & 15, ko = 8 * (lane >> 4); const bool live = row < 2;
    const bf16* bp = Bt + (size_t)(16 * ct + row) * K + ko;
    f32x4 acc = {0.f, 0.f, 0.f, 0.f};
    for (int s = 0; s < K / 32; s += 16) {
        bf16x8 a[16], b[16];
#pragma unroll
        for (int q = 0; q < 16; ++q) { b[q] = *(const bf16x8*)(bp + 32 * (s + q));
            v4u w = {0u, 0u, 0u, 0u};
            if (live) { const size_t o = (size_t)row * K + ko + 32 * (s + q);
                if (MODE == 0) w = *(const v4u*)((const bf16*)X0 + o);
                else { f32x4 p0 = *(const f32x4*)((const float*)X0 + o), p1 = *(const f32x4*)((const float*)X0 + o + 4);
                    if (MODE == 1) { p0 = p0 + *(const f32x4*)((const float*)X1 + o); p1 = p1 + *(const f32x4*)((const float*)X1 + o + 4); }
                    w.x = pk2(p0.x, p0.y); w.y = pk2(p0.z, p0.w); w.z = pk2(p1.x, p1.y); w.w = pk2(p1.z, p1.w); } }
            a[q] = __builtin_bit_cast(bf16x8, w); }
#pragma unroll
        for (int q = 0; q < 16; ++q) acc = __builtin_amdgcn_mfma_f32_16x16x32_bf16(a[q], b[q], acc, 0, 0, 0);
    }
    return acc;
}

__device__ __forceinline__ void p1_extras(Frame& F) {
    const int gw = F.vcu * 8 + F.wave, NGW = F.G * 8, lane = F.lane;
    for (int ct = gw; ct < 256; ct += NGW) {
        const f32x4 acc = skinny_tile((const bf16*)(F.ws + WS_XNM), (const bf16*)(F.ws + WS_WIN), 1024, ct, lane);
        const int col = 16 * ct + (lane & 15), fq = lane >> 4;
#pragma unroll
        for (int i = 0; i < 4; ++i) { const int r = 4 * fq + i;
            if (col < 2048) ((bf16*)(F.ws + WS_QKVUM))[(size_t)(col >> 9) * (16 * 512) + r * 512 + (col & 511)] = (bf16)(pk2(acc[i], 0.f) & 0xffffu);
            else ((bf16*)(F.ws + WS_GATEM))[r * 2048 + (col - 2048)] = (bf16)(pk2(fsigm(acc[i]), 0.f) & 0xffffu); }
    }
    const float* LOGF = (const float*)(F.ws + WS_LOGF); const float* LOGFM = (const float*)(F.ws + WS_LOGFM); float* CUMF = (float*)(F.ws + WS_CUMF);
    for (int sq = gw; sq < NB * NH; sq += NGW) { const int b = sq >> 3, h = sq & 7; float carry = 0.f;
        for (int p0 = 0; p0 < LTOT; p0 += 64) { const int p = p0 + lane;
            float v = 0.f; if (p < LTOT) v = p < NMETA ? LOGFM[p * 8 + h] : LOGF[(size_t)(b * SEQ + p - NMETA) * 8 + h];
#pragma unroll
            for (int o = 1; o < 64; o <<= 1) { const float t = __shfl_up(v, o); if (lane >= o) v += t; }
            v += carry; if (p < LTOT) CUMF[(size_t)sq * LTOT + p] = v; carry = __shfl(v, 63); } }
}

struct S5Regs { float l0r, l0i, l1r, l1i; bf16x8 Bf[4]; bf16x8 Cm[4]; float dsk; };
__device__ __forceinline__ void cw_sincos(float x, float& s, float& c) { s = sinf(x); c = cosf(x); }
__device__ __forceinline__ void s5_setup(const float* const* in, int g, int lane, S5Regs& R) {
    const int j = lane & 31, kq5 = lane >> 5;
    const float dt = expf(in[13][g]);
#pragma unroll
    for (int wh = 0; wh < 2; ++wh) { const int p = j + 32 * wh;
        const float lr = in[6][g * 64 + p], li = in[7][g * 64 + p];
        const float a = lr * dt, b = li * dt, ea = expf(a); float sb, cb; cw_sincos(b, sb, cb);
        const float lbr = ea * cb, lbi = ea * sb;
        const float sh = sinf(0.5f * b), nre = expm1f(a) * cb - 2.f * sh * sh, nim = ea * sb;
        const float den = 1.0f / (lr * lr + li * li), cre = (nre * lr + nim * li) * den, cim = (nim * lr - nre * li) * den;
        const f32x4* br = (const f32x4*)(in[8] + ((size_t)(g * 64 + p) * 16 + 8 * kq5)); const f32x4* bi = (const f32x4*)(in[9] + ((size_t)(g * 64 + p) * 16 + 8 * kq5));
        const f32x4 r0 = br[0], r1 = br[1], i0 = bi[0], i1 = bi[1];
        v4u re, im;
        re.x = pk2(cre * r0.x - cim * i0.x, cre * r0.y - cim * i0.y); re.y = pk2(cre * r0.z - cim * i0.z, cre * r0.w - cim * i0.w);
        re.z = pk2(cre * r1.x - cim * i1.x, cre * r1.y - cim * i1.y); re.w = pk2(cre * r1.z - cim * i1.z, cre * r1.w - cim * i1.w);
        im.x = pk2(cre * i0.x + cim * r0.x, cre * i0.y + cim * r0.y); im.y = pk2(cre * i0.z + cim * r0.z, cre * i0.w + cim * r0.w);
        im.z = pk2(cre * i1.x + cim * r1.x, cre * i1.y + cim * r1.y); im.w = pk2(cre * i1.z + cim * r1.z, cre * i1.w + cim * r1.w);
        R.Bf[2 * wh] = __builtin_bit_cast(bf16x8, re); R.Bf[2 * wh + 1] = __builtin_bit_cast(bf16x8, im);
        if (wh == 0) { R.l0r = lbr; R.l0i = lbi; } else { R.l1r = lbr; R.l1i = lbi; } }
    const int c = lane & 15, kq = lane >> 4;
    const float* cr = in[10] + (size_t)(g * 16 + c) * 64; const float* ci = in[11] + (size_t)(g * 16 + c) * 64;
#pragma unroll
    for (int s = 0; s < 4; ++s) { const int ja = 8 * s + 2 * kq, jb = ja + 1; v4u w;
        w.x = pk2(cr[ja], -ci[ja]); w.y = pk2(cr[ja + 32], -ci[ja + 32]); w.z = pk2(cr[jb], -ci[jb]); w.w = pk2(cr[jb + 32], -ci[jb + 32]);
        R.Cm[s] = __builtin_bit_cast(bf16x8, w); }
    R.dsk = in[12][g * 16 + c];
}
constexpr int S5_XP = 136;
template <bool FULL, class ZST>
__device__ __forceinline__ void s5_chunk(const S5Regs& R, const bf16x8 a, float (&x)[4], LAS bf16* X, LAS bf16* Ut, int lane, const ZST& zst) {
    f32x16 bu[4];
    const f32x16 zero = {0.f, 0.f, 0.f, 0.f, 0.f, 0.f, 0.f, 0.f, 0.f, 0.f, 0.f, 0.f, 0.f, 0.f, 0.f, 0.f};
#pragma unroll
    for (int q = 0; q < 4; ++q) bu[q] = __builtin_amdgcn_mfma_f32_32x32x16_bf16(a, R.Bf[q], zero, 0, 0, 0);
    const int j = lane & 31, hi = lane >> 5;
    if (FULL) { const int i = lane & 31, th = (i >> 2) & 1, r = (i & 3) + 4 * (i >> 3); *(LAS bf16x8*)(Ut + (16 * th + r) * 16 + 8 * hi) = a; }
#pragma unroll
    for (int r = 0; r < 16; ++r) {
        const float n0r = fmaf(R.l0r, x[0], fmaf(-R.l0i, x[1], bu[0][r])), n0i = fmaf(R.l0r, x[1], fmaf(R.l0i, x[0], bu[1][r]));
        const float n1r = fmaf(R.l1r, x[2], fmaf(-R.l1i, x[3], bu[2][r])), n1i = fmaf(R.l1r, x[3], fmaf(R.l1i, x[2], bu[3][r]));
        x[0] = n0r; x[1] = n0i; x[2] = n1r; x[3] = n1i;
        if (FULL) { v2u w; w.x = pk2(n0r, n0i); w.y = pk2(n1r, n1i); *(LAS v2u*)(X + (16 * hi + r) * S5_XP + 4 * j) = w; }
    }
    if (FULL) {
        LDS_WAIT(); asm volatile("" ::: "memory");
        const int c = lane & 15, fq = lane >> 4;
#pragma unroll
        for (int th = 0; th < 2; ++th) { f32x4 acc = {0.f, 0.f, 0.f, 0.f};
#pragma unroll
            for (int s = 0; s < 4; ++s) { const bf16x8 xa = *(const LAS bf16x8*)(X + (16 * th + c) * S5_XP + 32 * s + 8 * fq); acc = __builtin_amdgcn_mfma_f32_16x16x32_bf16(xa, R.Cm[s], acc, 0, 0, 0); }
#pragma unroll
            for (int i = 0; i < 4; ++i) { const int r = 4 * fq + i; const float y = acc[i] + R.dsk * bf2f(Ut[(16 * th + r) * 16 + c]);
                const float uu = 0.7978845608028654f * (y + 0.044715f * y * y * y); zst(th, r, c, y * fsigm(2.f * uu)); } }
        LDS_WAIT(); asm volatile("" ::: "memory");
    }
}
struct ZNone { __device__ __forceinline__ void operator()(int, int, int, float) const {} };
struct ZMain { bf16* z0; bf16* z1; __device__ __forceinline__ void operator()(int th, int r, int c, float v) const { (th ? z1 : z0)[(size_t)r * 512 + c] = (bf16)(pk2(v, 0.f) & 0xffffu); } };
struct ZMeta { bf16* za; __device__ __forceinline__ void operator()(int th, int r, int c, float v) const { if (th == 0 && r >= 14) za[(r - 14) * 512 + c] = (bf16)(pk2(v, 0.f) & 0xffffu); } };

__device__ __forceinline__ void s5_unit(Frame& F, int g, int bp) {
    const int lane = F.lane, w = F.wave;
    LAS bf16* X = (LAS bf16*)(F.lds + w * 10240); LAS bf16* Ut = (LAS bf16*)(F.lds + w * 10240 + 8704);
    LAS float* Ex = (LAS float*)(F.lds + 81920);
    S5Regs R; s5_setup(F.in, g, lane, R);
    const bf16* U = (const bf16*)(F.ws + WS_QKVU) + (size_t)3 * MROWS * 512; const bf16* UM = (const bf16*)(F.ws + WS_QKVUM) + 3 * 16 * 512;
    bf16* Z = (bf16*)(F.ws + WS_RB + 32 * MiB);
    const int i = lane & 31, kq5 = lane >> 5, th = (i >> 2) & 1, r = (i & 3) + 4 * (i >> 3);
    const bf16* upm = UM + r * 512 + 16 * g + 8 * kq5;
    const int t0 = 256 * w;
    const bf16* up0 = U + ((size_t)((2 * bp + th) * SEQ + t0 + r)) * 512 + 16 * g + 8 * kq5;
    float x[4] = {0.f, 0.f, 0.f, 0.f}; float xm[4] = {0.f, 0.f, 0.f, 0.f};
    if (w == 0) { s5_chunk<false>(R, *(const bf16x8*)upm, x, X, Ut, lane, ZNone{}); xm[0] = x[0]; xm[1] = x[1]; xm[2] = x[2]; xm[3] = x[3]; }
    { bf16x8 an = *(const bf16x8*)up0;
      for (int c = 0; c < 16; ++c) { const bf16x8 ac = an; if (c < 15) an = *(const bf16x8*)(up0 + (size_t)(c + 1) * 16 * 512); s5_chunk<false>(R, ac, x, X, Ut, lane, ZNone{}); } }
    *(LAS f32x4*)(Ex + (w * 64 + lane) * 4) = (f32x4){x[0], x[1], x[2], x[3]};
    __syncthreads();
    float p0r = R.l0r, p0i = R.l0i, p1r = R.l1r, p1i = R.l1i;
#pragma unroll
    for (int q = 0; q < 8; ++q) { const float a = p0r * p0r - p0i * p0i, b = 2.f * p0r * p0i, c2 = p1r * p1r - p1i * p1i, d = 2.f * p1r * p1i; p0r = a; p0i = b; p1r = c2; p1i = d; }
    if (w == 0) { x[0] = xm[0]; x[1] = xm[1]; x[2] = xm[2]; x[3] = xm[3]; }
    else { f32x4 e = *(const LAS f32x4*)(Ex + lane * 4);
        for (int v = 1; v < w; ++v) { const f32x4 ev = *(const LAS f32x4*)(Ex + (v * 64 + lane) * 4);
            const float a = ev[0] + p0r * e[0] - p0i * e[1], b = ev[1] + p0r * e[1] + p0i * e[0], c2 = ev[2] + p1r * e[2] - p1i * e[3], d = ev[3] + p1r * e[3] + p1i * e[2]; e = (f32x4){a, b, c2, d}; }
        x[0] = e[0]; x[1] = e[1]; x[2] = e[2]; x[3] = e[3]; }
    { bf16x8 an = *(const bf16x8*)up0;
      for (int c = 0; c < 16; ++c) { const int t = t0 + 16 * c; const bf16x8 ac = an; if (c < 15) an = *(const bf16x8*)(up0 + (size_t)(c + 1) * 16 * 512);
        ZMain zs{Z + ((size_t)((2 * bp) * SEQ + t)) * 512 + 16 * g, Z + ((size_t)((2 * bp + 1) * SEQ + t)) * 512 + 16 * g};
        s5_chunk<true>(R, ac, x, X, Ut, lane, zs); } }
    __syncthreads();
}

__device__ __forceinline__ void meta_p2(Frame& F) {
    const int tid = F.tid, lane = F.lane, w = F.wave, gw = F.vcu * 8 + w;
    bf16* aA = (bf16*)(F.ws + WS_AA); bf16* zA = (bf16*)(F.ws + WS_ZA);
    const bf16* QM = (const bf16*)(F.ws + WS_QKVUM); const bf16* KM = QM + 16 * 512; const bf16* VM = KM + 16 * 512; const bf16* UM = VM + 16 * 512;
    const float* LOGFM = (const float*)(F.ws + WS_LOGFM);
    if (gw < NG) { LAS bf16* X = (LAS bf16*)(F.lds + w * 10240); LAS bf16* Ut = (LAS bf16*)(F.lds + w * 10240 + 8704);
        const int i = lane & 31, kq5 = lane >> 5, r = (i & 3) + 4 * (i >> 3), g = gw;
        S5Regs R; s5_setup(F.in, g, lane, R); float x[4] = {0.f, 0.f, 0.f, 0.f};
        s5_chunk<true>(R, *(const bf16x8*)(UM + r * 512 + 16 * g + 8 * kq5), x, X, Ut, lane, ZMeta{zA + 16 * g}); }
    if (F.vcu == (F.G > 4 ? 4 : 0)) {
        LAS float* PM = (LAS float*)(F.lds + 98304);
        __syncthreads();
        if (tid < 256) { const int h = tid >> 5, qi = (tid >> 4) & 1, key = tid & 15, qp = 14 + qi;
            float s = 0.f;
            for (int d = 0; d < 64; ++d) s += bf2f(QM[qp * 512 + 64 * h + d]) * bf2f(KM[key * 512 + 64 * h + d]);
            float fq = 0.f, fk = 0.f;
            for (int p = 0; p < 16; ++p) { const float lf = LOGFM[p * 8 + h]; if (p <= qp) fq += lf; if (p <= key) fk += lf; }
            s = s * 0.125f + fq - fk; if (key > qp) s = -1e30f;
            float mx = s;
#pragma unroll
            for (int o = 1; o < 16; o <<= 1) mx = fmaxf(mx, __shfl_xor(mx, o));
            float p = expf(s - mx), sum = p;
#pragma unroll
            for (int o = 1; o < 16; o <<= 1) sum += __shfl_xor(sum, o);
            PM[(h * 2 + qi) * 16 + key] = p / sum; }
        __syncthreads();
        for (int o = tid; o < 1024; o += 512) { const int qi = o >> 9, col = o & 511, h = col >> 6; float a = 0.f;
            for (int k = 0; k < 16; ++k) a += PM[(h * 2 + qi) * 16 + k] * bf2f(VM[k * 512 + col]);
            aA[qi * 512 + col] = (bf16)(pk2(a, 0.f) & 0xffffu); }
        __syncthreads();
    }
}
__device__ __forceinline__ void meta_p3(Frame& F) {
    const int lane = F.lane, gw = F.vcu * 8 + F.wave;
    const bf16* GM = (const bf16*)(F.ws + WS_GATEM); float* YA = (float*)(F.ws + WS_MA); float* GY = YA + 2048;
    if (gw < 64) { const int ct = gw; const f32x4 acc = skinny2<0>(F.ws + WS_AA, nullptr, (const bf16*)(F.ws + WS_WA), 512, ct, lane);
        if (lane < 16) { const int col = 16 * ct + lane; YA[col] = acc[0] * bf2f(GM[14 * 2048 + col]); YA[1024 + col] = acc[1] * bf2f(GM[15 * 2048 + col]); } }
    else if (gw < 128) { const int pi = gw - 64, pn = pi >> 3, wi = pi & 7;
        const f32x4 av = skinny2<0>(F.ws + WS_ZA, nullptr, (const bf16*)(F.ws + WS_WG), 512, 16 * pn + wi, lane), ag = skinny2<0>(F.ws + WS_ZA, nullptr, (const bf16*)(F.ws + WS_WG), 512, 16 * pn + 8 + wi, lane);
        if (lane < 16) { const int ch = 128 * pn + 16 * wi + lane;
            GY[ch] = bf2f(GM[14 * 2048 + 1024 + ch]) * av[0] * fsigm(ag[0]); GY[1024 + ch] = bf2f(GM[15 * 2048 + 1024 + ch]) * av[1] * fsigm(ag[1]); } }
}
__device__ __forceinline__ void meta_p4(Frame& F) {
    const int lane = F.lane, gw = F.vcu * 8 + F.wave;
    const float* YA = (const float*)(F.ws + WS_MA); float* H1M = (float*)(F.ws + WS_HA);
    if (gw < 64) { const int ct = gw; const f32x4 acc = skinny2<1>(YA, YA + 2048, (const bf16*)(F.ws + WS_WO), 1024, ct, lane);
        if (lane < 16) { const int col = 16 * ct + lane; H1M[col] = F.in[1][14 * 1024 + col] + acc[0]; H1M[1024 + col] = F.in[1][15 * 1024 + col] + acc[1]; } }
}
__device__ __forceinline__ void meta_p5(Frame& F) {
    const int lane = F.lane, gw = F.vcu * 8 + F.wave, NGW = F.G * 8;
    const float* H1M = (const float*)(F.ws + WS_HA); float* EM = (float*)(F.ws + WS_EDGEM);
    for (int ct = gw; ct < 352; ct += NGW) {
        float s0 = 0.f, s1 = 0.f;
#pragma unroll
        for (int q = 0; q < 4; ++q) { const f32x4 a = ((const f32x4*)H1M)[lane + 64 * q], b = ((const f32x4*)(H1M + 1024))[lane + 64 * q];
            s0 += (a.x * a.x + a.y * a.y) + (a.z * a.z + a.w * a.w); s1 += (b.x * b.x + b.y * b.y) + (b.z * b.z + b.w * b.w); }
        const float r0 = rsqrtf(wave_sum(s0) * (1.f / 1024.f) + RMS_EPS), r1 = rsqrtf(wave_sum(s1) * (1.f / 1024.f) + RMS_EPS);
        const f32x4 acc = skinny2<2>(H1M, nullptr, (const bf16*)(F.ws + WS_WUP), 1024, ct, lane);
        if (lane < 16) { const int pn = ct >> 4, wi = ct & 15; const int hc = wi < 8 ? 128 * pn + 16 * wi + lane : FF + 128 * pn + 16 * (wi - 8) + lane;
            EM[hc] = r0 * acc[0]; EM[FF2 + hc] = r1 * acc[1]; } }
}

__device__ __forceinline__ int crow(int r, int hi) { return (r & 3) + 8 * (r >> 2) + 4 * hi; }
constexpr int AT_KP = 72, AT_VP = 68, AT_BUF = 64 * AT_KP * 2 + 64 * AT_VP * 2 + 256;
__device__ __forceinline__ void attn_unit(Frame& F, int b, int h, int qb) {
    const int tid = F.tid, lane = F.lane, w = F.wave, q = lane & 31, hi = lane >> 5;
    const bf16* Q = (const bf16*)(F.ws + WS_QKVU); const bf16* K = Q + (size_t)MROWS * 512; const bf16* V = K + (size_t)MROWS * 512;
    const bf16* KM = (const bf16*)(F.ws + WS_QKVUM) + 16 * 512; const bf16* VM = KM + 16 * 512;
    const float* CF = (const float*)(F.ws + WS_CUMF) + (size_t)(b * 8 + h) * LTOT;
    bf16* ATT = (bf16*)(F.ws + WS_RB);
    const int t0w = 256 * qb + 32 * w, pq = NMETA + t0w + q;
    const size_t rowq = (size_t)b * SEQ + t0w + q;
    bf16x8 Qf[4];
#pragma unroll
    for (int s = 0; s < 4; ++s) Qf[s] = *(const bf16x8*)(Q + rowq * 512 + 64 * h + 16 * s + 8 * hi);
    const float Fq = CF[pq] * LOG2E;
    const int ntiles = 4 * qb + 5, jmax = 4 * qb + ((32 * w + 47) >> 6);
    float mrun = -1e30f, lrun = 0.f;
    f32x16 O0, O1;
#pragma unroll
    for (int r = 0; r < 16; ++r) { O0[r] = 0.f; O1[r] = 0.f; }
    const int skey = tid >> 3, sch = tid & 7;
    v4u kreg, vreg; float fkreg = 0.f;
#define AT_LOAD(jt) do { const int p_ = 64 * (jt) + skey; const bf16 *kp_, *vp_; \
        if (p_ < NMETA) { kp_ = KM + p_ * 512; vp_ = VM + p_ * 512; } else { int rr_ = p_ - NMETA; rr_ = rr_ > SEQ - 1 ? SEQ - 1 : rr_; kp_ = K + ((size_t)b * SEQ + rr_) * 512; vp_ = V + ((size_t)b * SEQ + rr_) * 512; } \
        kreg = *(const v4u*)(kp_ + 64 * h + 8 * sch); vreg = *(const v4u*)(vp_ + 64 * h + 8 * sch); \
        if (tid < 64) { int pf_ = 64 * (jt) + tid; pf_ = pf_ > LTOT - 1 ? LTOT - 1 : pf_; fkreg = CF[pf_] * LOG2E; } } while (0)
    AT_LOAD(0);
    for (int jt = 0; jt < ntiles; ++jt) {
        LAS unsigned char* buf = F.lds + (jt & 1) * AT_BUF;
        LAS bf16* Ks = (LAS bf16*)buf; LAS bf16* Vt = (LAS bf16*)(buf + 64 * AT_KP * 2); LAS float* Fk = (LAS float*)(buf + 64 * AT_KP * 2 + 64 * AT_VP * 2);
        *(LAS v4u*)(Ks + skey * AT_KP + 8 * sch) = kreg;
        { const unsigned vv[4] = {vreg.x, vreg.y, vreg.z, vreg.w};
#pragma unroll
          for (int e = 0; e < 4; ++e) { Vt[(8 * sch + 2 * e) * AT_VP + skey] = (bf16)(vv[e] & 0xffffu); Vt[(8 * sch + 2 * e + 1) * AT_VP + skey] = (bf16)(vv[e] >> 16); } }
        if (tid < 64) Fk[tid] = fkreg;
        __syncthreads();
        if (jt + 1 < ntiles) AT_LOAD(jt + 1);
        if (jt <= jmax) {
            f32x16 p0, p1;
#pragma unroll
            for (int r = 0; r < 16; ++r) { p0[r] = 0.f; p1[r] = 0.f; }
#pragma unroll
            for (int s = 0; s < 4; ++s) {
                const bf16x8 k0 = *(const LAS bf16x8*)(Ks + q * AT_KP + 16 * s + 8 * hi), k1 = *(const LAS bf16x8*)(Ks + (32 + q) * AT_KP + 16 * s + 8 * hi);
                p0 = __builtin_amdgcn_mfma_f32_32x32x16_bf16(k0, Qf[s], p0, 0, 0, 0); p1 = __builtin_amdgcn_mfma_f32_32x32x16_bf16(k1, Qf[s], p1, 0, 0, 0); }
            const bool need_mask = (64 * jt + 63) > (NMETA + t0w);
            float mx = -1e30f;
#pragma unroll
            for (int g4 = 0; g4 < 4; ++g4) { const f32x4 f0 = *(const LAS f32x4*)(Fk + 8 * g4 + 4 * hi), f1 = *(const LAS f32x4*)(Fk + 32 + 8 * g4 + 4 * hi);
#pragma unroll
                for (int e = 0; e < 4; ++e) { const int r = 4 * g4 + e;
                    float a = fmaf(p0[r], 0.125f * LOG2E, Fq - f0[e]), c = fmaf(p1[r], 0.125f * LOG2E, Fq - f1[e]);
                    if (need_mask) { const int pk = 64 * jt + 8 * g4 + 4 * hi + e; if (pk > pq) a = -1e30f; if (pk + 32 > pq) c = -1e30f; }
                    p0[r] = a; p1[r] = c; mx = fmaxf(mx, fmaxf(a, c)); } }
            mx = fmaxf(mx, __shfl_xor(mx, 32));
            const float mnew = fmaxf(mrun, mx), alpha = __builtin_amdgcn_exp2f(mrun - mnew); mrun = mnew;
            float ps = 0.f;
#pragma unroll
            for (int r = 0; r < 16; ++r) { p0[r] = __builtin_amdgcn_exp2f(p0[r] - mnew); p1[r] = __builtin_amdgcn_exp2f(p1[r] - mnew); ps += p0[r] + p1[r]; }
            lrun = lrun * alpha + ps;
#pragma unroll
            for (int r = 0; r < 16; ++r) { O0[r] *= alpha; O1[r] *= alpha; }
#pragma unroll
            for (int t = 0; t < 4; ++t) {
                v4u pw;
                if (t < 2) { const int o = 8 * (t & 1); pw.x = pk2(p0[o], p0[o + 1]); pw.y = pk2(p0[o + 2], p0[o + 3]); pw.z = pk2(p0[o + 4], p0[o + 5]); pw.w = pk2(p0[o + 6], p0[o + 7]); }
                else { const int o = 8 * (t & 1); pw.x = pk2(p1[o], p1[o + 1]); pw.y = pk2(p1[o + 2], p1[o + 3]); pw.z = pk2(p1[o + 4], p1[o + 5]); pw.w = pk2(p1[o + 6], p1[o + 7]); }
                const bf16x8 pb = __builtin_bit_cast(bf16x8, pw);
                const int key0 = 32 * (t >> 1) + 16 * (t & 1) + 4 * hi;
                const v2u a0 = *(const LAS v2u*)(Vt + q * AT_VP + key0), a1 = *(const LAS v2u*)(Vt + q * AT_VP + key0 + 8);
                const v2u b0 = *(const LAS v2u*)(Vt + (32 + q) * AT_VP + key0), b1 = *(const LAS v2u*)(Vt + (32 + q) * AT_VP + key0 + 8);
                const v4u va = {a0.x, a0.y, a1.x, a1.y}, vb = {b0.x, b0.y, b1.x, b1.y};
                O0 = __builtin_amdgcn_mfma_f32_32x32x16_bf16(__builtin_bit_cast(bf16x8, va), pb, O0, 0, 0, 0);
                O1 = __builtin_amdgcn_mfma_f32_32x32x16_bf16(__builtin_bit_cast(bf16x8, vb), pb, O1, 0, 0, 0);
            }
        }
    }
#undef AT_LOAD
    const float inv = 1.0f / (lrun + __shfl_xor(lrun, 32));
    bf16* op = ATT + rowq * 512 + 64 * h;
#pragma unroll
    for (int g4 = 0; g4 < 4; ++g4) { v2u w0, w1;
        w0.x = pk2(O0[4 * g4] * inv, O0[4 * g4 + 1] * inv); w0.y = pk2(O0[4 * g4 + 2] * inv, O0[4 * g4 + 3] * inv);
        w1.x = pk2(O1[4 * g4] * inv, O1[4 * g4 + 1] * inv); w1.y = pk2(O1[4 * g4 + 2] * inv, O1[4 * g4 + 3] * inv);
        *(v2u*)(op + 8 * g4 + 4 * hi) = w0; *(v2u*)(op + 32 + 8 * g4 + 4 * hi) = w1; }
    __syncthreads();
}

__device__ __forceinline__ void p6_fixup(Frame& F) {
    const float* EDGE = (const float*)(F.ws + WS_EDGE); const float* EM = (const float*)(F.ws + WS_EDGEM);
    const float* CPT = (const float*)(F.ws + WS_CPT); bf16* ACT = (bf16*)(F.ws + WS_ACT);
    const int total = 512 * 2 * (FF / 4);
    for (int i = blockIdx.x * 512 + F.tid; i < total; i += F.G * 512) {
        const int c4 = (i % (FF / 4)) * 4, rr = (i / (FF / 4)) & 1, rb = i / (2 * (FF / 4));
        const bool first = (rb & 31) == 0;
        const float* e0 = EDGE + (size_t)rb * 8 * FF + c4; const float* ep = EDGE + (size_t)(rb - 1) * 8 * FF + c4;
        f32x4 v0, v1, v2, g0, g1, g2;
        if (rr == 0) { v0 = *(const f32x4*)(e0); g0 = *(const f32x4*)(e0 + FF);
            if (first) { v2 = *(const f32x4*)(EM + c4); g2 = *(const f32x4*)(EM + FF + c4); v1 = *(const f32x4*)(EM + FF2 + c4); g1 = *(const f32x4*)(EM + FF2 + FF + c4); }
            else { v2 = *(const f32x4*)(ep + 4 * FF); g2 = *(const f32x4*)(ep + 5 * FF); v1 = *(const f32x4*)(ep + 6 * FF); g1 = *(const f32x4*)(ep + 7 * FF); } }
        else { v0 = *(const f32x4*)(e0 + 2 * FF); g0 = *(const f32x4*)(e0 + 3 * FF); v1 = *(const f32x4*)(e0); g1 = *(const f32x4*)(e0 + FF);
            if (first) { v2 = *(const f32x4*)(EM + FF2 + c4); g2 = *(const f32x4*)(EM + FF2 + FF + c4); } else { v2 = *(const f32x4*)(ep + 6 * FF); g2 = *(const f32x4*)(ep + 7 * FF); } }
        f32x4 cp[8];
#pragma unroll
        for (int k = 0; k < 8; ++k) cp[k] = *(const f32x4*)(CPT + k * FF + c4);
        const f32x4 ov = cp[3] + cp[0] * v2 + cp[1] * v1 + cp[2] * v0, og = cp[7] + cp[4] * g2 + cp[5] * g1 + cp[6] * g0;
        float o[4];
#pragma unroll
        for (int e = 0; e < 4; ++e) o[e] = og[e] * fsigm(og[e]) * ov[e];
        v2u w; w.x = pk2(o[0], o[1]); w.y = pk2(o[2], o[3]);
        *(v2u*)(ACT + (size_t)(64 * rb + rr) * FF + c4) = w;
    }
}

__device__ __forceinline__ void p8_final(Frame& F) {
    const int gw = F.vcu * 8 + F.wave, NGW = F.G * 8, lane = F.lane;
    const float* rowss = (const float*)(F.ws + WS_ROWSS2); const bf16* H2 = (const bf16*)(F.ws + WS_RA);
    f32x4 gv[4];
#pragma unroll
    for (int j = 0; j < 4; ++j) gv[j] = ((const f32x4*)F.in[21])[lane + 64 * j];
    v2u vn[4]; float rn = 0.f;
    if (gw < MROWS) { const v2u* o = (const v2u*)(H2 + (size_t)gw * DM) + lane; rn = rowss[gw];
#pragma unroll
        for (int j = 0; j < 4; ++j) vn[j] = o[64 * j]; }
    for (int m = gw; m < MROWS; m += NGW) { v2u v[4]; const float rc = rn;
#pragma unroll
        for (int j = 0; j < 4; ++j) v[j] = vn[j];
        if (m + NGW < MROWS) { const v2u* o = (const v2u*)(H2 + (size_t)(m + NGW) * DM) + lane; rn = rowss[m + NGW];
#pragma unroll
            for (int j = 0; j < 4; ++j) vn[j] = o[64 * j]; }
        const float rstd = rsqrtf(rc * (1.f / DM) + RMS_EPS); f32x4* o = (f32x4*)(F.out + (size_t)m * DM) + lane;
#pragma unroll
        for (int j = 0; j < 4; ++j) o[64 * j] = (f32x4){blo(v[j].x), bhi(v[j].x), blo(v[j].y), bhi(v[j].y)} * rstd * gv[j]; }
}

#define XB_TMO      128
#define XB_XCNT(j)  (256  + 64 * (j))
#define XB_XSUB(j)  (1280 + 64 * (j))
#define XB_XGEN(j)  (2304 + 64 * (j))
#define XB_TOP      3328
#define XB_TOPGEN   3392
#define XCD_BAR_WORDS 3456
#define XB_SPIN_CAP (1u << 18)

__device__ __forceinline__ unsigned xb_ld(unsigned* p)              { return __hip_atomic_load(p, __ATOMIC_RELAXED, __HIP_MEMORY_SCOPE_AGENT); }
__device__ __forceinline__ unsigned xb_add(unsigned* p, unsigned v) { return __hip_atomic_fetch_add(p, v, __ATOMIC_RELAXED, __HIP_MEMORY_SCOPE_AGENT); }
__device__ __forceinline__ unsigned xb_xcc_id() { return (unsigned)__builtin_amdgcn_s_getreg((3 << 11) | 20) & 0xFu; }
#define XB_SPIN(cond, bar) do { unsigned _sp = 0; while (cond) { __builtin_amdgcn_s_sleep(1); \
    if ((++_sp & 255u) == 0u) { if (xb_ld(&(bar)[XB_TMO])) break; if (_sp > XB_SPIN_CAP) { atomicAdd(&(bar)[XB_TMO], 1u); break; } } } } while (0)

struct XcdBarrier {
    unsigned* bar; unsigned x;
    volatile LAS unsigned* st;
};

__device__ __forceinline__ XcdBarrier xcd_barrier_post(unsigned* bar, volatile LAS unsigned* st) {
    XcdBarrier b; b.bar = bar; b.x = xb_xcc_id(); b.st = st;
    if (threadIdx.x == 0) (void)xb_add(&bar[XB_XCNT(b.x)], 1u);
    return b;
}
__device__ __forceinline__ void xcd_barrier_complete(unsigned* bar, unsigned x, unsigned& nloc, unsigned& nx) {
    const unsigned G = gridDim.x * gridDim.y * gridDim.z;
    unsigned sum, cnt, mine, sp = 0u;
    for (;;) {
        sum = 0u; cnt = 0u; mine = 0u;
#pragma unroll
        for (unsigned j = 0; j < 16; ++j) { const unsigned c = xb_ld(&bar[XB_XCNT(j)]); sum += c; cnt += (c > 0u) ? 1u : 0u; mine = (j == x) ? c : mine; }
        if (sum == G) break;
        __builtin_amdgcn_s_sleep(1);
        if ((++sp & 255u) == 0u) { if (xb_ld(&bar[XB_TMO])) break; if (sp > XB_SPIN_CAP) { atomicAdd(&bar[XB_TMO], 1u); break; } }
    }
    nloc = mine > 0u ? mine : 1u; nx = cnt > 0u ? cnt : 1u;
}

__device__ __forceinline__ void xcd_barrier(const XcdBarrier& b) {
    asm volatile("s_waitcnt vmcnt(0)" ::: "memory");
    __syncthreads();
    if (threadIdx.x == 0) {
        unsigned* bar = b.bar;
        __builtin_amdgcn_s_waitcnt(0);
        unsigned nloc = b.st[0], nx = b.st[1];
        if (nloc == 0u) { xcd_barrier_complete(bar, b.x, nloc, nx); b.st[0] = nloc; b.st[1] = nx; }
        const unsigned old = xb_add(&bar[XB_XSUB(b.x)], 1u);
        const unsigned gen = old / nloc;
        if (old + 1u == (gen + 1u) * nloc) {
            __builtin_amdgcn_fence(__ATOMIC_RELEASE, "agent");
            asm volatile("s_waitcnt vmcnt(0)" ::: "memory");
            const unsigned og = xb_add(&bar[XB_TOP], 1u);
            const unsigned tg = og / nx;
            if (og + 1u == (tg + 1u) * nx) xb_add(&bar[XB_TOPGEN], 1u);
            else XB_SPIN(xb_ld(&bar[XB_TOPGEN]) == tg, bar);
            __builtin_amdgcn_fence(__ATOMIC_ACQUIRE, "agent");
            xb_add(&bar[XB_XGEN(b.x)], 1u);
            asm volatile("s_waitcnt vmcnt(0)" ::: "memory");
        } else {
            XB_SPIN(xb_ld(&bar[XB_XGEN(b.x)]) == gen, bar);
            __builtin_amdgcn_fence(__ATOMIC_ACQUIRE, "agent");
            asm volatile("s_waitcnt vmcnt(0)" ::: "memory");
        }
    }
    __syncthreads();
}

#ifndef MK_SKIP
#define MK_SKIP 0
#endif
#ifndef MK_REP
#define MK_REP 0
#endif
#ifndef MK_PROBE_ON
#define MK_PROBE_ON 0
#define MK_PROBE_A 0
#define MK_PROBE_B 9
#endif
__global__ void __launch_bounds__(512, 2) mk_fwd(Args args) {
    extern __shared__ __attribute__((aligned(16))) unsigned char lds_raw[];
    Frame F;
    F.lds = (LAS unsigned char*)lds_raw; F.ws = args.ws; F.in = args.in; F.out = args.out;
    F.tid = threadIdx.x; F.lane = F.tid & 63; F.wave = __builtin_amdgcn_readfirstlane(F.tid >> 6);
    F.G = gridDim.x; { const int bx = blockIdx.x; F.vcu = (F.G % 8 == 0) ? (bx % 8) * (F.G / 8) + bx / 8 : bx; }
    const int lo = args.ph_lo, hi = args.ph_hi;
    XcdBarrier bar; bar.bar = (unsigned*)(args.ws + WS_BAR); bar.x = 0; bar.st = nullptr;
    if (hi - lo > 1) {
        volatile LAS unsigned* st = (volatile LAS unsigned*)(F.lds + 131072 + 64);
        if (F.tid < 2) st[F.tid] = 0u;
        __syncthreads();
        bar = xcd_barrier_post((unsigned*)(args.ws + WS_BAR), st);
    }
#if MK_PROBE_ON
    unsigned long long ts_a = 0, ts_b = 0;
#define STAMP(k) do { if ((k) == MK_PROBE_A) ts_a = __builtin_amdgcn_s_memrealtime(); if ((k) == MK_PROBE_B) ts_b = __builtin_amdgcn_s_memrealtime(); } while (0)
#else
#define STAMP(k) do {} while (0)
#endif
#define IN(k) (lo <= (k) && (k) < hi)
#define SEAM(k) do { if (IN(k) && IN((k) + 1)) xcd_barrier(bar); } while (0)
    unsigned char* ws = args.ws;
    bf16* QKVU = (bf16*)(ws + WS_QKVU); bf16* GATE = (bf16*)(ws + WS_GATE);

    STAMP(0);
#if !((MK_SKIP >> 0) & 1)
#if (MK_REP & 64)
    for (int q = 0; q < 8; ++q) xcd_barrier(bar);
#endif
    if (IN(0)) { p0_prologue(F); __syncthreads(); }
#if (MK_REP & 1)
    xcd_barrier(bar); if (IN(0)) { p0_prologue(F); __syncthreads(); }
#endif
#endif
    SEAM(0);

    STAMP(1);
#if !((MK_SKIP >> 1) & 1)
    if (IN(1)) {
        p1_extras(F);
        pg8::Gemm g{(const bf16*)(ws + WS_RA), (const bf16*)(ws + WS_WIN), MROWS, 4096, 1024}; pg8::StaticOrder S; S.init(MROWS, 4096, F.G, (int)blockIdx.x);
        pg8::EpiProj E{QKVU, GATE};
        pg8::gemm_phase<pg8::EpiProj, pg8::StaticOrder, true, true>(F.lds, g, S, E);
#if (MK_REP & 2)
        xcd_barrier(bar); pg8::gemm_phase<pg8::EpiProj, pg8::StaticOrder, true, true>(F.lds, g, S, E);
#endif
    }
#endif
    SEAM(1);

    STAMP(2);
#if !((MK_SKIP >> 2) & 1)
    if (IN(2)) {
        meta_p2(F);
        for (int rep = 0; rep < 1 + ((MK_REP >> 2) & 1); ++rep)
        for (int u = F.vcu; u < 256; u += F.G) s5_unit(F, u & 31, u >> 5);
        for (int rep = 0; rep < 1 + ((MK_REP >> 3) & 1); ++rep)
        for (int pu = F.vcu; pu < 512; pu += F.G) { const int bh = pu >> 2, qp = pu & 3; attn_unit(F, bh >> 3, bh & 7, 7 - qp); attn_unit(F, bh >> 3, bh & 7, qp); }
    }
#endif
    SEAM(2);

    STAMP(3);
#if !((MK_SKIP >> 3) & 1)
    if (IN(3)) {
        meta_p3(F);
        { pg8::Gemm g{(const bf16*)(ws + WS_RB), (const bf16*)(ws + WS_WA), MROWS, 1024, 512}; pg8::PairOrder S{F.G, F.vcu, 2};
          pg8::EpiYa E{GATE, (bf16*)F.out};
          pg8::gemm_phase<pg8::EpiYa, pg8::PairOrder, true, true>(F.lds, g, S, E); }
        { pg8::Gemm g{(const bf16*)(ws + WS_RB + 32 * MiB), (const bf16*)(ws + WS_WG), MROWS, 2048, 512}; pg8::PairOrder S{F.G, F.vcu, 4};
          pg8::EpiGlu E{GATE, (const bf16*)F.out, (bf16*)(ws + WS_RA)};
          pg8::gemm_phase<pg8::EpiGlu, pg8::PairOrder, true, true>(F.lds, g, S, E); }
    }
#endif
    SEAM(3);

    STAMP(4);
#if !((MK_SKIP >> 4) & 1)
    if (IN(4)) {
        meta_p4(F);
        pg8::Gemm g{(const bf16*)(ws + WS_RA), (const bf16*)(ws + WS_WO), MROWS, 1024, 1024}; pg8::StaticOrder S; S.init(MROWS, 1024, F.G, (int)blockIdx.x);
        pg8::EpiWo E{F.in[0], (bf16*)(ws + WS_RB), (float*)(ws + WS_ROWSS1)};
        pg8::gemm_phase<pg8::EpiWo, pg8::StaticOrder, true, true>(F.lds, g, S, E);
    }
#endif
    SEAM(4);

    STAMP(5);
#if !((MK_SKIP >> 5) & 1)
    if (IN(5)) {
        meta_p5(F);
        pg8::Gemm g{(const bf16*)(ws + WS_RB), (const bf16*)(ws + WS_WUP), MROWS, FF2, 1024}; pg8::StaticOrder S; S.init(MROWS, FF2, F.G, (int)blockIdx.x);
        pg8::EpiUp E{(const float*)(ws + WS_ROWSS1), (const float*)(ws + WS_CP), (bf16*)(ws + WS_ACT), (float*)(ws + WS_EDGE)};
        pg8::gemm_phase<pg8::EpiUp, pg8::StaticOrder, true, true>(F.lds, g, S, E);
#if (MK_REP & 32)
        xcd_barrier(bar); pg8::gemm_phase<pg8::EpiUp, pg8::StaticOrder, true, true>(F.lds, g, S, E);
#endif
    }
#endif
    SEAM(5);

    STAMP(6);
#if !((MK_SKIP >> 6) & 1)
    if (IN(6)) { p6_fixup(F); }
#endif
    SEAM(6);

    STAMP(7);
#if !((MK_SKIP >> 7) & 1)
    if (IN(7)) {
        pg8::Gemm g{(const bf16*)(ws + WS_ACT), (const bf16*)(ws + WS_WDN), MROWS, 1024, FF}; pg8::StaticOrder S; S.init(MROWS, 1024, F.G, (int)blockIdx.x);
        pg8::EpiDown E{(const bf16*)(ws + WS_RB), (bf16*)(ws + WS_RA), (float*)(ws + WS_ROWSS2)};
        pg8::gemm_phase<pg8::EpiDown, pg8::StaticOrder, true, true>(F.lds, g, S, E);
    }
#endif
    SEAM(7);

    STAMP(8);
#if !((MK_SKIP >> 8) & 1)
    if (IN(8)) { p8_final(F); }
#endif
    STAMP(9);
#if MK_PROBE_ON
    __syncthreads();
    if (blockIdx.x == 0 && F.tid == 0) F.out[0] += (float)(ts_b - ts_a) * 0.0001f;
#endif
#undef IN
#undef SEAM
}

extern "C" void kernel_launch(void* const* d_in, const int* in_sizes, int n_in, void* d_out, int out_size, void* d_ws, size_t ws_size, hipStream_t stream) {
    static int grid = 0;
    if (grid == 0) {
        if (n_in != 22 || in_sizes[0] != MROWS * DM || out_size != MROWS * DM || ws_size < WS_END) { fprintf(stderr, "kernel_launch: unexpected shapes / workspace (n_in %d, ws %zu)\n", n_in, ws_size); grid = -1; return; }
        int dev = 0, cus = 0, per_cu = 0;
        if (hipGetDevice(&dev) != hipSuccess || hipDeviceGetAttribute(&cus, hipDeviceAttributeMultiprocessorCount, dev) != hipSuccess) { grid = -1; return; }
        if (hipFuncSetAttribute((const void*)mk_fwd, hipFuncAttributeMaxDynamicSharedMemorySize, LDS_BYTES) != hipSuccess) { fprintf(stderr, "kernel_launch: hipFuncSetAttribute failed\n"); grid = -1; return; }
        if (hipOccupancyMaxActiveBlocksPerMultiprocessor(&per_cu, (const void*)mk_fwd, 512, LDS_BYTES) != hipSuccess || per_cu < 1) { fprintf(stderr, "kernel_launch: occupancy query failed (%d)\n", per_cu); (void)hipGetLastError(); per_cu = 1; }
        grid = cus * per_cu;
        if (grid > 256) grid = 256;
    }
    if (grid < 0) return;
    Args a{};
    for (int i = 0; i < 22; ++i) a.in[i] = (const float*)d_in[i];
    a.out = (float*)d_out; a.ws = (unsigned char*)d_ws;
#if MK_PER_PHASE
    for (int p = 0; p < NPHASE; ++p) { a.ph_lo = p; a.ph_hi = p + 1; hipLaunchKernelGGL(mk_fwd, dim3(grid), dim3(512), LDS_BYTES, stream, a); }
#else
    a.ph_lo = 0; a.ph_hi = NPHASE;
    if (hipMemsetAsync((char*)d_ws + WS_BAR, 0, 16384, stream) != hipSuccess) { fprintf(stderr, "kernel_launch: memset of the barrier words failed\n"); return; }
    hipLaunchKernelGGL(mk_fwd, dim3(grid), dim3(512), LDS_BYTES, stream, a);
#endif
}
```
